# Optimizing an MI355X kernel written in HIP

```python
import jax
import jax.numpy as jnp
from jax import lax
import numpy as np

D_MODEL = 1024
BATCH = 16
SEQ = 2048
DEPTH = 2

HEAD_DIM = 64
SB_HEADS = 8
FOX_HEADS = 8
DSA_HEADS = 8
DSA_KV_HEADS = 2
DSA_GROUP = DSA_HEADS // DSA_KV_HEADS
IDX_HEADS = 4
IDX_DIM = 64
BRANCH_WIDTH = SB_HEADS * HEAD_DIM
N_BRANCH = 3
D_FF = 4 * D_MODEL
ROPE_THETA = 500000.0
ROT_DIM = HEAD_DIM // 4
Q_BLOCK = 128
TOPK_MAX = 256
NORM_EPS = 1e-6

COL_SIZES = (
    SB_HEADS * HEAD_DIM, SB_HEADS * HEAD_DIM, SB_HEADS * HEAD_DIM,
    FOX_HEADS * HEAD_DIM, FOX_HEADS * HEAD_DIM, FOX_HEADS * HEAD_DIM,
    FOX_HEADS,
    DSA_HEADS * HEAD_DIM, DSA_KV_HEADS * HEAD_DIM, DSA_KV_HEADS * HEAD_DIM,
    IDX_HEADS * IDX_DIM, IDX_DIM, IDX_HEADS,
    N_BRANCH * D_MODEL,
)
COL_TOTAL = sum(COL_SIZES)
COL_SPLITS = tuple(sum(COL_SIZES[:i + 1]) for i in range(len(COL_SIZES) - 1))

kernel_name = 'hybrid_gated_sb_fox_dsa_trunk'


def _rmsnorm(x, g):
    xf = x.astype(jnp.float32)
    y = xf * lax.rsqrt(jnp.mean(xf * xf, axis=-1, keepdims=True) + NORM_EPS)
    return (y * g.astype(jnp.float32)).astype(x.dtype)


def _partial_rope(x, positions):
    half = ROT_DIM // 2
    inv_freq = ROPE_THETA ** (-jnp.arange(0, ROT_DIM, 2, dtype=jnp.float32) / ROT_DIM)
    ang = positions.astype(jnp.float32)[:, :, None] * inv_freq
    cos = jnp.cos(ang)[:, :, None, :]
    sin = jnp.sin(ang)[:, :, None, :]
    xf = x.astype(jnp.float32)
    x1, x2, rest = xf[..., :half], xf[..., half:ROT_DIM], xf[..., ROT_DIM:]
    out = jnp.concatenate([x1 * cos - x2 * sin, x2 * cos + x1 * sin, rest], axis=-1)
    return out.astype(x.dtype)


def _to_blocks(a):
    b, s = a.shape[0], a.shape[1]
    return jnp.moveaxis(a.reshape(b, s // Q_BLOCK, Q_BLOCK, *a.shape[2:]), 1, 0)


def _from_blocks(a):
    a = jnp.moveaxis(a, 0, 1)
    return a.reshape(a.shape[0], a.shape[1] * a.shape[2], *a.shape[3:])


def _stick_breaking_attention(q, k, v):
    b, s, h, dh = q.shape
    scale = dh ** -0.5
    kf = k.astype(jnp.float32)
    vf = v.astype(jnp.float32)
    s_idx = jnp.arange(s)
    t_blk = jnp.arange(s).reshape(s // Q_BLOCK, Q_BLOCK)

    def block(args):
        qb, tb = args
        z = jnp.einsum('bthd,bshd->bhts', qb.astype(jnp.float32), kf) * scale
        strict = s_idx[None, :] < tb[:, None]
        log_beta = jax.nn.log_sigmoid(z)
        log_1m = jnp.where(strict, jax.nn.log_sigmoid(-z), 0.0)
        later = lax.cumsum(log_1m, axis=3, reverse=True) - log_1m
        w = jnp.where(strict, jnp.exp(log_beta + later), 0.0)
        return jnp.einsum('bhts,bshd->bthd', w, vf)

    out = lax.map(block, (_to_blocks(q), t_blk))
    return _from_blocks(out).reshape(b, s, h * dh).astype(q.dtype)


def _forgetting_attention(q, k, v, log_f):
    b, s, h, dh = q.shape
    scale = dh ** -0.5
    kf = k.astype(jnp.float32)
    vf = v.astype(jnp.float32)
    c = jnp.cumsum(log_f, axis=1).transpose(0, 2, 1)
    c_blk = jnp.moveaxis(c.reshape(b, h, s // Q_BLOCK, Q_BLOCK), 2, 0)
    s_idx = jnp.arange(s)
    t_blk = jnp.arange(s).reshape(s // Q_BLOCK, Q_BLOCK)

    def block(args):
        qb, cb, tb = args
        z = jnp.einsum('bthd,bshd->bhts', qb.astype(jnp.float32), kf) * scale
        z = z + cb[..., None] - c[:, :, None, :]
        causal = s_idx[None, :] <= tb[:, None]
        p = jax.nn.softmax(jnp.where(causal, z, -jnp.inf), axis=-1)
        return jnp.einsum('bhts,bshd->bthd', p, vf)

    out = lax.map(block, (_to_blocks(q), c_blk, t_blk))
    return _from_blocks(out).reshape(b, s, h * dh).astype(q.dtype)


def _indexed_sparse_attention(q, k, v, q_idx, k_idx, w_idx, top_k):
    b, s, g, r, dh = q.shape
    scale = dh ** -0.5
    kif = k_idx.astype(jnp.float32)
    s_idx = jnp.arange(s)
    t_blk = jnp.arange(s).reshape(s // Q_BLOCK, Q_BLOCK)
    gather = jax.vmap(lambda a, i: a[i])

    def block(args):
        qb, qib, wb, tb = args
        dots = jnp.einsum('bthi,bsi->bths', qib.astype(jnp.float32), kif) * (IDX_DIM ** -0.5)
        score = jnp.einsum('bth,bths->bts', wb.astype(jnp.float32) * (IDX_HEADS ** -0.5),
                           jax.nn.relu(dots))
        causal = s_idx[None, :] <= tb[:, None]
        score = jnp.where(causal[None], score, -jnp.inf)
        _, sel = lax.top_k(score, top_k)
        valid = sel <= tb[None, :, None]
        k_sel = gather(k, sel).astype(jnp.float32)
        v_sel = gather(v, sel).astype(jnp.float32)
        z = jnp.einsum('btgrd,btkgd->btgrk', qb.astype(jnp.float32), k_sel) * scale
        z = jnp.where(valid[:, :, None, None, :], z, -jnp.inf)
        p = jax.nn.softmax(z, axis=-1)
        return jnp.einsum('btgrk,btkgd->btgrd', p, v_sel)

    out = lax.map(block, (_to_blocks(q), _to_blocks(q_idx), _to_blocks(w_idx), t_blk))
    return _from_blocks(out).reshape(b, s, g * r * dh).astype(q.dtype)


def _layer(x, positions, g_mix, w_in, b_forget, w_branch, w_out, g_mlp, w_up, w_down):
    b, s, _ = x.shape
    h = _rmsnorm(x, g_mix)
    proj = h @ w_in
    (qa, ka, va, qb, kb, vb, fl, qc, kc, vc, qi, ki, wi, gl) = jnp.split(proj, COL_SPLITS, axis=-1)

    def heads(a, n):
        return a.reshape(b, s, n, -1)

    br_a = _stick_breaking_attention(heads(qa, SB_HEADS), heads(ka, SB_HEADS), heads(va, SB_HEADS))
    log_f = jax.nn.log_sigmoid((fl + b_forget).astype(jnp.float32))
    br_b = _forgetting_attention(heads(qb, FOX_HEADS), heads(kb, FOX_HEADS),
                                 heads(vb, FOX_HEADS), log_f)
    qc = _partial_rope(heads(qc, DSA_HEADS), positions).reshape(b, s, DSA_KV_HEADS, DSA_GROUP, HEAD_DIM)
    kc = _partial_rope(heads(kc, DSA_KV_HEADS), positions)
    vc = heads(vc, DSA_KV_HEADS)
    qi = _partial_rope(heads(qi, IDX_HEADS), positions)
    ki = _partial_rope(ki[:, :, None, :], positions)[:, :, 0, :]
    top_k = min(TOPK_MAX, s // 4)
    br_c = _indexed_sparse_attention(qc, kc, vc, qi, ki, wi, top_k)

    gates = jax.nn.sigmoid(gl.reshape(b, s, N_BRANCH, D_MODEL))
    y = (gates[:, :, 0, :] * (br_a @ w_branch[0])
         + gates[:, :, 1, :] * (br_b @ w_branch[1])
         + gates[:, :, 2, :] * (br_c @ w_branch[2]))
    x = x + y @ w_out

    h2 = _rmsnorm(x, g_mlp)
    x = x + jnp.square(jax.nn.relu(h2 @ w_up)) @ w_down
    return x


def setup_inputs(seed: int = 0) -> dict:
    key = jax.random.key(seed)
    ks = jax.random.split(key, 12)
    f32 = jnp.float32
    x = jax.random.normal(ks[0], (BATCH, SEQ, D_MODEL), f32)
    positions = jnp.broadcast_to(jnp.arange(SEQ, dtype=jnp.int32), (BATCH, SEQ))
    g_mix = 1.0 + 0.02 * jax.random.normal(ks[1], (DEPTH, D_MODEL), f32)
    w_in = jax.random.normal(ks[2], (DEPTH, D_MODEL, COL_TOTAL), f32) * D_MODEL ** -0.5
    b_forget = jax.random.uniform(ks[3], (DEPTH, FOX_HEADS), f32, minval=1.0, maxval=4.0)
    w_branch = jax.random.normal(ks[4], (DEPTH, N_BRANCH, BRANCH_WIDTH, D_MODEL), f32) * BRANCH_WIDTH ** -0.5
    w_out = jax.random.normal(ks[5], (DEPTH, D_MODEL, D_MODEL), f32) * D_MODEL ** -0.5
    g_mlp = 1.0 + 0.02 * jax.random.normal(ks[6], (DEPTH, D_MODEL), f32)
    w_up = jax.random.normal(ks[7], (DEPTH, D_MODEL, D_FF), f32) * D_MODEL ** -0.5
    w_down = jax.random.normal(ks[8], (DEPTH, D_FF, D_MODEL), f32) * D_FF ** -0.5
    g_final = 1.0 + 0.02 * jax.random.normal(ks[9], (D_MODEL,), f32)
    return {'x': x, 'positions': positions, 'g_mix': g_mix, 'w_in': w_in,
            'b_forget': b_forget, 'w_branch': w_branch, 'w_out': w_out,
            'g_mlp': g_mlp, 'w_up': w_up, 'w_down': w_down, 'g_final': g_final}


def reference(x, positions, g_mix, w_in, b_forget, w_branch, w_out, g_mlp, w_up, w_down, g_final):
    for layer in range(DEPTH):
        x = _layer(x, positions, g_mix[layer], w_in[layer], b_forget[layer], w_branch[layer],
                   w_out[layer], g_mlp[layer], w_up[layer], w_down[layer])
    return _rmsnorm(x, g_final)
```

```cpp
#include <hip/hip_runtime.h>
#include <cstdio>
#include <cstdint>

#ifndef PROBE_DUP
#define PROBE_DUP 0
#endif
#ifndef PROBE_ATT1
#define PROBE_ATT1 0
#endif
#ifndef PG8_ALIGN
#define PG8_ALIGN 1
#endif
#ifndef MK_ONE_LAUNCH
#define MK_ONE_LAUNCH 1
#endif

#define LAS __attribute__((address_space(3)))
#define GAS __attribute__((address_space(1)))
typedef unsigned short bf16_t;
typedef short bf16x8 __attribute__((ext_vector_type(8)));
typedef short s16x4 __attribute__((ext_vector_type(4)));
typedef float f32x4 __attribute__((ext_vector_type(4)));
typedef float f32x2 __attribute__((ext_vector_type(2)));
typedef float f32x16 __attribute__((ext_vector_type(16)));
typedef unsigned u32x4 __attribute__((ext_vector_type(4)));
typedef unsigned u32x2 __attribute__((ext_vector_type(2)));
typedef __bf16 bf16x2_t __attribute__((ext_vector_type(2)));
typedef GAS unsigned gu32;

__device__ __forceinline__ unsigned pk2(float lo, float hi) { f32x2 v = {lo, hi}; bf16x2_t b = __builtin_convertvector(v, bf16x2_t); return __builtin_bit_cast(unsigned, b); }
__device__ __forceinline__ u32x4 pk8(const f32x4& a, const f32x4& b) { u32x4 w; w.x = pk2(a[0], a[1]); w.y = pk2(a[2], a[3]); w.z = pk2(b[0], b[1]); w.w = pk2(b[2], b[3]); return w; }
__device__ __forceinline__ float bf2f(unsigned short h) { return __builtin_bit_cast(float, (unsigned)h << 16); }


__device__ __forceinline__ int otid() { int t = threadIdx.x; asm volatile("" : "+v"(t)); return t; }
__device__ __forceinline__ unsigned char* optr(unsigned char* p) { asm volatile("" : "+s"(p)); return p; }

constexpr int SEQ = 2048, DM = 1024, NBATCH = 16, MTOK = NBATCH * SEQ, MH = MTOK / 2, FF = 4096;
constexpr int NIN = 7424;
constexpr int COLT = 7244;
constexpr float LOG2E = 1.4426950408889634f;
constexpr float C2S = 0.125f * LOG2E;
constexpr float NEGBIG = -1.0e30f;

constexpr size_t MiB = 1u << 20;
constexpr size_t WS_CTL = 0, CTL_ZERO_BYTES = 1 * MiB;
constexpr size_t WS_W = 2 * MiB, W_LAYER = 36 * MiB;
constexpr size_t W_IN = 0, W_BR = 15 * MiB, W_OUT = 18 * MiB, W_UP = 20 * MiB, W_DN = 28 * MiB;
constexpr size_t WS_XB = 74 * MiB;
constexpr size_t WS_RS = 138 * MiB;
constexpr size_t WS_CS = 139 * MiB;
constexpr size_t WS_KI = 141 * MiB;
constexpr size_t WS_WI = 143 * MiB;
constexpr size_t WS_LF = 143 * MiB + 512 * 1024;
constexpr size_t WS_SEL = 144 * MiB;
constexpr size_t WS_QKV = 148 * MiB;
constexpr size_t WS_CB = 244 * MiB;
constexpr size_t WS_G = 276 * MiB;
constexpr size_t WS_Y = 372 * MiB;
constexpr size_t WS_HID = 148 * MiB;
constexpr size_t WS_XL = 436 * MiB;
constexpr size_t WS_END = 500 * MiB;
static_assert(WS_HID + (size_t)MTOK * FF * 2 <= WS_END, "hidden overlay");
constexpr int CW_TMO = 0, CW_BAR = 4096, CW_Q = 8192;
constexpr size_t SS_OFF = 262144, SS_STRIDE = 131072;

constexpr int LDS_BYTES = 147456;
constexpr int MISC_OFF = LDS_BYTES - 256;
constexpr int NWAVES = 8;

#define XB_TMO      128
#define XB_XCNT(j)  (256  + 64 * (j))
#define XB_XSUB(j)  (1280 + 64 * (j))
#define XB_XGEN(j)  (2304 + 64 * (j))
#define XB_TOP      3328
#define XB_TOPGEN   3392
#define XCD_BAR_WORDS 3456
#define XB_SPIN_CAP (1u << 18)
__device__ __forceinline__ unsigned xb_ld(unsigned* p)              { return __hip_atomic_load(p, __ATOMIC_RELAXED, __HIP_MEMORY_SCOPE_AGENT); }
__device__ __forceinline__ unsigned xb_add(unsigned* p, unsigned v) { return __hip_atomic_fetch_add(p, v, __ATOMIC_RELAXED, __HIP_MEMORY_SCOPE_AGENT); }
__device__ __forceinline__ unsigned xb_xcc_id() { return (unsigned)__builtin_amdgcn_s_getreg((3 << 11) | 20) & 0xFu; }
#define XB_SPIN(cond, bar) do { unsigned _sp = 0; while (cond) { __builtin_amdgcn_s_sleep(1); \
    if ((++_sp & 255u) == 0u) { if (xb_ld(&(bar)[XB_TMO])) break; if (_sp > XB_SPIN_CAP) { atomicAdd(&(bar)[XB_TMO], 1u); break; } } } } while (0)
struct XcdBarrier { unsigned* bar; unsigned x; volatile LAS unsigned* st; };
__device__ __forceinline__ XcdBarrier xcd_barrier_post(unsigned* bar, volatile LAS unsigned* st) {
    XcdBarrier b; b.bar = bar; b.x = xb_xcc_id(); b.st = st;
    if (threadIdx.x == 0) (void)xb_add(&bar[XB_XCNT(b.x)], 1u);
    return b;
}
__device__ __forceinline__ void xcd_barrier_complete(unsigned* bar, unsigned x, unsigned& nloc, unsigned& nx) {
    const unsigned G = gridDim.x * gridDim.y * gridDim.z;
    unsigned sum, cnt, mine, sp = 0u;
    for (;;) {
        sum = 0u; cnt = 0u; mine = 0u;
#pragma unroll
        for (unsigned j = 0; j < 16; ++j) { const unsigned c = xb_ld(&bar[XB_XCNT(j)]); sum += c; cnt += (c > 0u) ? 1u : 0u; mine = (j == x) ? c : mine; }
        if (sum == G) break;
        __builtin_amdgcn_s_sleep(1);
        if ((++sp & 255u) == 0u) { if (xb_ld(&bar[XB_TMO])) break; if (sp > XB_SPIN_CAP) { atomicAdd(&bar[XB_TMO], 1u); break; } }
    }
    nloc = mine > 0u ? mine : 1u; nx = cnt > 0u ? cnt : 1u;
}
__device__ __forceinline__ void xcd_barrier(const XcdBarrier& b) {
    asm volatile("s_waitcnt vmcnt(0)" ::: "memory");
    __syncthreads();
    if (threadIdx.x == 0) {
        unsigned* bar = b.bar;
        __builtin_amdgcn_s_waitcnt(0);
        unsigned nloc = b.st[0], nx = b.st[1];
        if (nloc == 0u) { xcd_barrier_complete(bar, b.x, nloc, nx); b.st[0] = nloc; b.st[1] = nx; }
        const unsigned old = xb_add(&bar[XB_XSUB(b.x)], 1u);
        const unsigned gen = old / nloc;
        if (old + 1u == (gen + 1u) * nloc) {
            __builtin_amdgcn_fence(__ATOMIC_RELEASE, "agent");
            asm volatile("s_waitcnt vmcnt(0)" ::: "memory");
            const unsigned og = xb_add(&bar[XB_TOP], 1u);
            const unsigned tg = og / nx;
            if (og + 1u == (tg + 1u) * nx) xb_add(&bar[XB_TOPGEN], 1u);
            else XB_SPIN(xb_ld(&bar[XB_TOPGEN]) == tg, bar);
            __builtin_amdgcn_fence(__ATOMIC_ACQUIRE, "agent");
            xb_add(&bar[XB_XGEN(b.x)], 1u);
            asm volatile("s_waitcnt vmcnt(0)" ::: "memory");
        } else {
            XB_SPIN(xb_ld(&bar[XB_XGEN(b.x)]) == gen, bar);
            __builtin_amdgcn_fence(__ATOMIC_ACQUIRE, "agent");
            asm volatile("s_waitcnt vmcnt(0)" ::: "memory");
        }
    }
    __syncthreads();
}

namespace pg8 {
constexpr int BM = 256, BK = 64, HALF = 128, HTB = HALF * BK * 2, STAGE_BYTES = 8 * HTB, NXCD = 8, WGM = 8;
__host__ __device__ __forceinline__ int lds_byte(int r, int c) { const int st = (r >> 4) * 2 + (c >> 5), rr = r & 15, cc = c & 31, ob = rr * 64 + cc * 2; return st * 1024 + (ob ^ (((ob >> 9) & 1) << 5)); }
__host__ __device__ __forceinline__ void stage_rc(int b, int& R, int& C) { const int st = b / 1024, sb = b % 1024, swz = sb ^ (((sb >> 9) & 1) << 5); R = (st >> 1) * 16 + swz / 64; C = (st & 1) * 32 + (swz % 64) / 2; }
__host__ __device__ __forceinline__ int perm32(int rho) { const int n = rho >> 4, i = rho & 15; return 8 * (i >> 2) + 4 * n + (i & 3); }

struct Unit { int pm, pn, sub; const char* A; const char* B; };

template <int nM, int nN, int nsub, int LDA, int LDB, int bsubE, int asub1, int asub2>
struct TileOrder {
    static constexpr int nwg = nM * nN; static constexpr size_t atile = (size_t)256 * LDA * 2, btile = (size_t)256 * LDB * 2, bsub = (size_t)bsubE * 2;
    int G, c;
    const char* A; const char* B;
    __device__ __forceinline__ bool next(int i, Unit& u) const {
        const int ti = i / nsub, sub = i - ti * nsub;
        const long L = (long)ti * G + c; if (L >= nwg) return false;
        int wgid = (int)L; { const int q = nwg / NXCD, r = nwg % NXCD, xcd = wgid % NXCD, off = wgid / NXCD; wgid = (xcd < r ? xcd * (q + 1) : r * (q + 1) + (xcd - r) * q) + off; }
        const int nig = WGM * nN, gid = wgid / nig, fm = gid * WGM, gsz = (nM - fm) < WGM ? (nM - fm) : WGM;
        u.pm = fm + ((wgid % nig) % gsz); u.pn = (wgid % nig) / gsz; u.sub = sub;
        u.A = A + (size_t)u.pm * atile + (sub == 0 ? 0 : (sub == 1 ? asub1 : asub2));
        u.B = B + (size_t)u.pn * btile + (size_t)sub * bsub;
        return true;
    }
};

template <int K, int lda, int ldb, class Epi, class Sched>
__device__ __forceinline__ void gemm_phase(LAS unsigned char* lds, const Sched& S, const Epi& E) {
    const int tid = otid(), wid = __builtin_amdgcn_readfirstlane(tid >> 6), lane = tid & 63, wr = wid >> 2, wc = wid & 3, fr = lane & 15, fq = lane >> 4;
    constexpr int nt = K / BK;
    unsigned voffA[2], voffB[2];
#pragma unroll
    for (int i = 0; i < 2; ++i) { int R, C; stage_rc(tid * 16 + i * 8192, R, C); const int Rb = (R & ~31) + perm32(R & 31);
        voffA[i] = (unsigned)(R * lda + C) * 2u; voffB[i] = (unsigned)(Rb * ldb + C) * 2u; }
    const size_t kstep = (size_t)(BK * 2);
    const size_t hstepA = (size_t)HALF * lda * 2, hstepB = (size_t)HALF * ldb * 2;
    const unsigned ldsw = (unsigned)wid * 1024u;
    const int aoff = lds_byte(wr * 64 + fr, fq * 8), boff = lds_byte(wc * 32 + fr, fq * 8);
#define PG8_SA(b, h) (((b) * 2 + (h)) * HTB)
#define PG8_SB(b, h) ((4 + (b) * 2 + (h)) * HTB)
#define PG8_STAGE(bufoff, gbase, voff) do { _Pragma("unroll") for (int _i = 0; _i < 2; ++_i) \
        __builtin_amdgcn_global_load_lds((const unsigned*)((const char*)(gbase) + (voff)[_i]), (LAS unsigned*)(lds + (bufoff) + ldsw + _i * 8192), 16, 0, 0); } while (0)
#define PG8_LDA(dst, b, h) do { _Pragma("unroll") for (int m = 0; m < 4; ++m) _Pragma("unroll") for (int k = 0; k < 2; ++k) dst[m][k] = *(const LAS bf16x8*)(lds + PG8_SA(b, h) + aoff + m * 2048 + k * 1024); } while (0)
#define PG8_LDB(dst, b, h) do { _Pragma("unroll") for (int n = 0; n < 2; ++n) _Pragma("unroll") for (int k = 0; k < 2; ++k) dst[n][k] = *(const LAS bf16x8*)(lds + PG8_SB(b, h) + boff + n * 2048 + k * 1024); } while (0)
#define PG8_MMA(ai, bj, At, Bt) do { __builtin_amdgcn_s_setprio(1); _Pragma("unroll") for (int m = 0; m < 4; ++m) _Pragma("unroll") for (int n = 0; n < 2; ++n) _Pragma("unroll") for (int k = 0; k < 2; ++k) \
        acc[ai][bj][m][n] = __builtin_amdgcn_mfma_f32_16x16x32_bf16(Bt[n][k], At[m][k], acc[ai][bj][m][n], 0, 0, 0); __builtin_amdgcn_s_setprio(0); } while (0)
#define PG8_WAIT_V(n) asm volatile("s_waitcnt vmcnt(" #n ")" ::: "memory")
#define PG8_WAIT_L(n) asm volatile("s_waitcnt lgkmcnt(" #n ")" ::: "memory")
#define PG8_BAR __builtin_amdgcn_s_barrier()
#define PG8_SCHED __builtin_amdgcn_sched_barrier(0)
    Unit cur, nxt; int ui = 0;
    if (!S.next(0, cur)) return;
    f32x4 acc[2][2][4][2];
#pragma unroll
    for (int a = 0; a < 2; ++a)
#pragma unroll
        for (int b = 0; b < 2; ++b)
#pragma unroll
            for (int m = 0; m < 4; ++m)
#pragma unroll
                for (int n = 0; n < 2; ++n) acc[a][b][m][n] = (f32x4){0.f, 0.f, 0.f, 0.f};
    bf16x8 At[4][2], B0[2][2], B1[2][2];
    const char* cA = cur.A; const char* cB = cur.B;
    PG8_STAGE(PG8_SB(0, 0), cB, voffB); PG8_STAGE(PG8_SB(0, 1), cB + hstepB, voffB); PG8_STAGE(PG8_SA(0, 0), cA, voffA); PG8_STAGE(PG8_SA(0, 1), cA + hstepA, voffA);
    if (wr == 1) PG8_BAR;
    PG8_WAIT_V(2); PG8_BAR;
    PG8_STAGE(PG8_SB(1, 0), cB + kstep, voffB); PG8_STAGE(PG8_SA(1, 0), cA + kstep, voffA); PG8_STAGE(PG8_SB(1, 1), cB + hstepB + kstep, voffB);
    PG8_WAIT_V(6); PG8_BAR;
    for (;;) {
        const bool has_next = S.next(ui + 1, nxt);
        const char* nA = has_next ? nxt.A : cA; const char* nB = has_next ? nxt.B : cB;
        for (int t = 0; t < nt; t += 2) {
            const bool last = (t == nt - 2);
            const char* a1 = cA + (size_t)(t + 1) * kstep;
            const char* a2 = last ? nA : cA + (size_t)(t + 2) * kstep; const char* b2 = last ? nB : cB + (size_t)(t + 2) * kstep;
            const char* a3 = a2 + kstep; const char* b3 = b2 + kstep;
            PG8_LDB(B0, 0, 0); PG8_LDB(B1, 0, 1); PG8_SCHED; PG8_LDA(At, 0, 0); PG8_STAGE(PG8_SA(1, 1), a1 + hstepA, voffA);
            PG8_WAIT_V(8); PG8_WAIT_L(0); PG8_BAR; PG8_MMA(0, 0, At, B0); PG8_MMA(0, 1, At, B1); PG8_BAR; PG8_SCHED;
            PG8_LDA(At, 0, 1); PG8_STAGE(PG8_SB(0, 0), b2, voffB); PG8_STAGE(PG8_SB(0, 1), b2 + hstepB, voffB); PG8_STAGE(PG8_SA(0, 0), a2, voffA);
            PG8_WAIT_V(8); PG8_WAIT_L(0); PG8_BAR; PG8_MMA(1, 0, At, B0); PG8_MMA(1, 1, At, B1); PG8_BAR; PG8_SCHED;
            PG8_LDB(B0, 1, 0); PG8_LDB(B1, 1, 1); PG8_SCHED; PG8_LDA(At, 1, 0); PG8_STAGE(PG8_SA(0, 1), a2 + hstepA, voffA);
            PG8_WAIT_V(8); PG8_WAIT_L(0); PG8_BAR; PG8_MMA(0, 0, At, B0); PG8_MMA(0, 1, At, B1); PG8_BAR; PG8_SCHED;
            PG8_LDA(At, 1, 1); PG8_STAGE(PG8_SB(1, 0), b3, voffB); PG8_STAGE(PG8_SB(1, 1), b3 + hstepB, voffB); PG8_STAGE(PG8_SA(1, 0), a3, voffA);
            PG8_WAIT_V(8); PG8_WAIT_L(0); PG8_BAR; PG8_MMA(1, 0, At, B0); PG8_MMA(1, 1, At, B1); PG8_BAR; PG8_SCHED;
        }
        if (PG8_ALIGN) { if (wr == 0) PG8_BAR; }
        E(acc, cur, wr, wc, fr, fq);
        if (!has_next) break;
        if (nxt.sub == 0) {
#pragma unroll
            for (int a = 0; a < 2; ++a)
#pragma unroll
                for (int b = 0; b < 2; ++b)
#pragma unroll
                    for (int m = 0; m < 4; ++m)
#pragma unroll
                        for (int n = 0; n < 2; ++n) acc[a][b][m][n] = (f32x4){0.f, 0.f, 0.f, 0.f};
        }
        cur = nxt; cA = nA; cB = nB; ++ui;
        if (PG8_ALIGN) { if (wr == 1) PG8_BAR; }
    }
    PG8_WAIT_V(0);
    if (!PG8_ALIGN) { if (wr == 0) PG8_BAR; }
    PG8_BAR;
#undef PG8_SA
#undef PG8_SB
#undef PG8_STAGE
#undef PG8_LDA
#undef PG8_LDB
#undef PG8_MMA
#undef PG8_WAIT_V
#undef PG8_WAIT_L
#undef PG8_BAR
#undef PG8_SCHED
}

__device__ __forceinline__ float sigmoidf_(float v) { return __builtin_amdgcn_rcpf(1.0f + __builtin_amdgcn_exp2f(-LOG2E * v)); }
__device__ __forceinline__ float rs_of(float ss) { return __builtin_amdgcn_rsqf(ss * (1.0f / DM) + 1e-6f); }
__device__ __forceinline__ float logsigmoidf_(float x) { return fminf(x, 0.f) - log1pf(__expf(-fabsf(x))); }

struct EpiInProj {
    GAS bf16_t* QKV; GAS bf16_t* CB; GAS unsigned char* G; GAS bf16_t* KI; GAS float* WI; GAS float* LF; const GAS float* SS; const GAS float* CS; const GAS float* bfg; int tok0;
    __device__ __forceinline__ void operator()(f32x4 (&acc)[2][2][4][2], const Unit& u, int wr, int wc, int fr, int fq) const {
        const int pn = u.pn; const int rbase = u.pm * BM + wr * 64 + fr; const int cw = wc * 32 + 8 * fq;
        if (pn < 12) {
            const float sc = (pn < 2 || pn == 6 || pn == 7) ? C2S : 1.0f;
#pragma unroll
            for (int ai = 0; ai < 2; ++ai)
#pragma unroll
                for (int m = 0; m < 4; ++m) { const int row = rbase + ai * HALF + m * 16; const float rs = rs_of(SS[tok0 + row]) * sc; GAS bf16_t* rowp = QKV + (size_t)row * 3072 + pn * 256 + cw;
#pragma unroll
                    for (int bj = 0; bj < 2; ++bj) *(GAS u32x4*)(rowp + bj * HALF) = pk8(acc[ai][bj][m][0] * rs, acc[ai][bj][m][1] * rs); }
        } else if (pn < 16) {
            const bool ropew = ((wc & 1) == 0);
#pragma unroll
            for (int ai = 0; ai < 2; ++ai)
#pragma unroll
                for (int m = 0; m < 4; ++m) { const int row = rbase + ai * HALF + m * 16; const float rs = rs_of(SS[tok0 + row]);
                    f32x4 c0 = {0, 0, 0, 0}, c1 = c0, s0 = c0, s1 = c0;
                    if (ropew) { const GAS f32x4* cp = (const GAS f32x4*)(CS + (size_t)(tok0 + row) * 16); c0 = cp[0]; c1 = cp[1]; s0 = cp[2]; s1 = cp[3]; }
#pragma unroll
                    for (int bj = 0; bj < 2; ++bj) { const int cl = (pn - 12) * 256 + bj * HALF + cw;
                        f32x4 v0 = acc[ai][bj][m][0] * rs, v1 = acc[ai][bj][m][1] * rs;
                        if (ropew && !(pn == 14 && bj == 1)) {
                            const float sg = (fq == 0) ? -1.f : 1.f;
#pragma unroll
                            for (int e = 0; e < 4; ++e) { const float p0 = __shfl_xor(v0[e], 16), p1 = __shfl_xor(v1[e], 16);
                                const float r0 = v0[e] * c0[e] + sg * p0 * s0[e], r1 = v1[e] * c1[e] + sg * p1 * s1[e];
                                if (fq < 2) { v0[e] = r0; v1[e] = r1; } }
                        }
                        const float sc = (cl < 512) ? C2S : ((cl >= 768) ? 0.125f : 1.0f);
                        *(GAS u32x4*)(CB + (size_t)row * 1024 + cl) = pk8(v0 * sc, v1 * sc); } }
        } else {
#pragma unroll
            for (int ai = 0; ai < 2; ++ai)
#pragma unroll
                for (int m = 0; m < 4; ++m) { const int row = rbase + ai * HALF + m * 16; const float rs = rs_of(SS[tok0 + row]); GAS unsigned char* rowp = G + (size_t)row * 3072 + (pn - 16) * 256 + cw;
#pragma unroll
                    for (int bj = 0; bj < 2; ++bj) { f32x4 v0 = acc[ai][bj][m][0] * rs, v1 = acc[ai][bj][m][1] * rs;
                        unsigned w0 = 0u, w1 = 0u;
#pragma unroll
                        for (int e = 0; e < 4; ++e) { w0 = __builtin_amdgcn_cvt_pk_u8_f32(__builtin_rintf(sigmoidf_(v0[e]) * 255.0f), e, w0); w1 = __builtin_amdgcn_cvt_pk_u8_f32(__builtin_rintf(sigmoidf_(v1[e]) * 255.0f), e, w1); }
                        *(GAS u32x2*)(rowp + bj * HALF) = (u32x2){w0, w1}; } }
        }
    }
};

struct EpiBranch {
    const GAS unsigned char* G; GAS bf16_t* Y; int tok0;
    __device__ __forceinline__ void operator()(f32x4 (&acc)[2][2][4][2], const Unit& u, int wr, int wc, int fr, int fq) const {
        const int rbase = u.pm * BM + wr * 64 + fr; const int cw = u.pn * 256 + wc * 32 + 8 * fq; const int sub = u.sub;
#pragma unroll
        for (int ai = 0; ai < 2; ++ai)
#pragma unroll
            for (int m = 0; m < 4; ++m) { const int row = rbase + ai * HALF + m * 16; const GAS unsigned char* gp = G + (size_t)row * 3072 + sub * 1024 + cw;
#pragma unroll
                for (int bj = 0; bj < 2; ++bj) {
                    const u32x2 ga = *(const GAS u32x2*)(gp + bj * HALF);
                    float f[8];
                    if (sub < 2) { const u32x2 gb = *(const GAS u32x2*)(gp + 1024 + bj * HALF);
#pragma unroll
                        for (int e = 0; e < 8; ++e) { const float a = (float)((ga[e >> 2] >> (8 * (e & 3))) & 0xffu), b = fmaxf((float)((gb[e >> 2] >> (8 * (e & 3))) & 0xffu), 0.25f);
                            f[e] = ((sub == 0) ? a : fmaxf(a, 0.25f)) * __builtin_amdgcn_rcpf(b); }
                    } else {
#pragma unroll
                        for (int e = 0; e < 8; ++e) f[e] = fmaxf((float)((ga[e >> 2] >> (8 * (e & 3))) & 0xffu), 0.25f) * (1.0f / 255.0f);
                    }
                    f32x4 v0 = acc[ai][bj][m][0], v1 = acc[ai][bj][m][1];
                    v0[0] *= f[0]; v0[1] *= f[1]; v0[2] *= f[2]; v0[3] *= f[3]; v1[0] *= f[4]; v1[1] *= f[5]; v1[2] *= f[6]; v1[3] *= f[7];
                    if (sub < 2) { acc[ai][bj][m][0] = v0; acc[ai][bj][m][1] = v1; }
                    else *(GAS u32x4*)(Y + (size_t)(tok0 + row) * 1024 + cw + bj * HALF) = pk8(v0, v1);
                } }
    }
};

struct EpiResid {
    GAS bf16_t* XB; GAS bf16_t* XL; GAS float* SS;
    __device__ __forceinline__ void operator()(f32x4 (&acc)[2][2][4][2], const Unit& u, int wr, int wc, int fr, int fq) const {
        const int rbase = u.pm * BM + wr * 64 + fr; const int cw = u.pn * 256 + wc * 32 + 8 * fq;
#pragma unroll
        for (int ai = 0; ai < 2; ++ai)
#pragma unroll
            for (int m = 0; m < 4; ++m) { const int row = rbase + ai * HALF + m * 16; const size_t off = (size_t)row * 1024 + cw; float ss = 0.f;
#pragma unroll
                for (int bj = 0; bj < 2; ++bj) { const u32x4 h = *(const GAS u32x4*)(XB + off + bj * HALF), l = *(const GAS u32x4*)(XL + off + bj * HALF);
                    float x[8];
#pragma unroll
                    for (int e = 0; e < 4; ++e) { x[2 * e] = __uint_as_float(h[e] << 16) + __uint_as_float(l[e] << 16); x[2 * e + 1] = __uint_as_float(h[e] & 0xffff0000u) + __uint_as_float(l[e] & 0xffff0000u); }
#pragma unroll
                    for (int e = 0; e < 4; ++e) { x[e] += acc[ai][bj][m][0][e]; x[4 + e] += acc[ai][bj][m][1][e]; }
                    u32x4 hn, ln;
#pragma unroll
                    for (int e = 0; e < 4; ++e) { hn[e] = pk2(x[2 * e], x[2 * e + 1]);
                        ln[e] = pk2(x[2 * e] - __uint_as_float(hn[e] << 16), x[2 * e + 1] - __uint_as_float(hn[e] & 0xffff0000u)); }
                    *(GAS u32x4*)(XB + off + bj * HALF) = hn; *(GAS u32x4*)(XL + off + bj * HALF) = ln;
#pragma unroll
                    for (int e = 0; e < 8; ++e) ss += x[e] * x[e]; }
                ss += __shfl_xor(ss, 16); ss += __shfl_xor(ss, 32);
                if (fq == 0) __hip_atomic_fetch_add(SS + row, ss, __ATOMIC_RELAXED, __HIP_MEMORY_SCOPE_AGENT); }
    }
};

struct EpiUp {
    GAS bf16_t* H; const GAS float* SS;
    __device__ __forceinline__ void operator()(f32x4 (&acc)[2][2][4][2], const Unit& u, int wr, int wc, int fr, int fq) const {
        const int rbase = u.pm * BM + wr * 64 + fr; const int cw = u.pn * 256 + wc * 32 + 8 * fq;
#pragma unroll
        for (int ai = 0; ai < 2; ++ai)
#pragma unroll
            for (int m = 0; m < 4; ++m) { const int row = rbase + ai * HALF + m * 16; const float rs = rs_of(SS[row]); GAS bf16_t* rowp = H + (size_t)row * FF + cw;
#pragma unroll
                for (int bj = 0; bj < 2; ++bj) { f32x4 v0 = acc[ai][bj][m][0] * rs, v1 = acc[ai][bj][m][1] * rs;
#pragma unroll
                    for (int e = 0; e < 4; ++e) { const float a = fmaxf(v0[e], 0.f), b = fmaxf(v1[e], 0.f); v0[e] = a * a; v1[e] = b * b; }
                    *(GAS u32x4*)(rowp + bj * HALF) = pk8(v0, v1); } }
    }
};
}

namespace att {
__device__ __forceinline__ int crow(int r, int hi) { return (r & 3) + 8 * (r >> 2) + 4 * hi; }
typedef short v4i16_t __attribute__((ext_vector_type(4)));
__device__ __forceinline__ s16x4 vtr(const LAS unsigned char* p) { return __builtin_bit_cast(s16x4, __builtin_amdgcn_ds_read_tr16_b64_v4i16((LAS v4i16_t*)p)); }
__device__ __forceinline__ bf16x8 mk8(const s16x4& lo, const s16x4& hi) { return (bf16x8){lo[0], lo[1], lo[2], lo[3], hi[0], hi[1], hi[2], hi[3]}; }
#define CFENCE() asm volatile("" ::: "memory")
__device__ __forceinline__ void xswap(float v, float& a_, float& b_) {
    unsigned a = __builtin_bit_cast(unsigned, v), b = a;
    asm volatile("s_nop 1\n\tv_permlane32_swap_b32 %0, %1\n\ts_nop 1" : "+v"(a), "+v"(b));
    a_ = __builtin_bit_cast(float, a); b_ = __builtin_bit_cast(float, b);
}
__device__ __forceinline__ float xmax(float v) { float a, b; xswap(v, a, b); return fmaxf(a, b); }
__device__ __forceinline__ float xsum(float v) { float a, b; xswap(v, a, b); return a + b; }

__device__ __forceinline__ void pv_tile(f32x16 (&ot)[2], const f32x16& p0, const f32x16& p1, const LAS unsigned char* vimg, int lane) {
    const int hi = lane >> 5;
    const LAS unsigned char* vb = vimg + ((lane >> 4) & 1) * 32 + (lane & 3) * 8 + (4 * hi + ((lane & 15) >> 2)) * 64;
    bf16x8 pf[4];
    { u32x4 w;
      w.x = pk2(p0[0], p0[1]); w.y = pk2(p0[2], p0[3]); w.z = pk2(p0[4], p0[5]); w.w = pk2(p0[6], p0[7]); pf[0] = __builtin_bit_cast(bf16x8, w);
      w.x = pk2(p0[8], p0[9]); w.y = pk2(p0[10], p0[11]); w.z = pk2(p0[12], p0[13]); w.w = pk2(p0[14], p0[15]); pf[1] = __builtin_bit_cast(bf16x8, w);
      w.x = pk2(p1[0], p1[1]); w.y = pk2(p1[2], p1[3]); w.z = pk2(p1[4], p1[5]); w.w = pk2(p1[6], p1[7]); pf[2] = __builtin_bit_cast(bf16x8, w);
      w.x = pk2(p1[8], p1[9]); w.y = pk2(p1[10], p1[11]); w.z = pk2(p1[12], p1[13]); w.w = pk2(p1[14], p1[15]); pf[3] = __builtin_bit_cast(bf16x8, w); }
#pragma unroll
    for (int db = 0; db < 2; ++db)
#pragma unroll
        for (int ks = 0; ks < 4; ++ks) {
            const s16x4 lo = vtr(vb + db * 4096 + ks * 1024), hh = vtr(vb + db * 4096 + ks * 1024 + 512);
            ot[db] = __builtin_amdgcn_mfma_f32_32x32x16_bf16(mk8(lo, hh), pf[ks], ot[db], 0, 0, 0);
        }
}
__device__ __forceinline__ void store_ot(const f32x16 (&ot)[2], float scale, GAS bf16_t* obase  , int ldo, LAS unsigned char* stage, int lane) {
    const int ql = lane & 31, hi = lane >> 5;
#pragma unroll
    for (int db = 0; db < 2; ++db)
#pragma unroll
        for (int g = 0; g < 4; ++g) { u32x2 w; w.x = pk2(ot[db][4 * g] * scale, ot[db][4 * g + 1] * scale); w.y = pk2(ot[db][4 * g + 2] * scale, ot[db][4 * g + 3] * scale);
            *(LAS u32x2*)(stage + ql * 144 + (db * 32 + 8 * g + 4 * hi) * 2) = w; }
    CFENCE();
#pragma unroll
    for (int i = 0; i < 4; ++i) { const int id = i * 64 + lane, row = id >> 3, ch = id & 7;
        const u32x4 v = *(const LAS u32x4*)(stage + row * 144 + ch * 16);
        *(GAS u32x4*)(obase + (size_t)row * ldo + ch * 8) = v; }
    CFENCE();
}

template <int MODE, int ldq, int ldkv, int ldo>
__device__ __forceinline__ void flash_unit(LAS unsigned char* lds, const GAS bf16_t* Qp, const GAS bf16_t* Kp, const GAS bf16_t* Vp, GAS bf16_t* Op,
                                           int qb, const GAS float* lf, const GAS unsigned* seli) {
    constexpr float THR = 8.0f;
    const int tid = otid(), lane = tid & 63, wid = __builtin_amdgcn_readfirstlane(tid >> 6), ql = lane & 31, hi = lane >> 5;
    const int blk = (wid < 4) ? wid : 11 - wid;
    const int q0 = qb * 256, qs = q0 + blk * 32, NT = 4 * (qb + 1);
    LAS float* cbias = (LAS float*)(lds + 32768);
    LAS unsigned* cbw = (LAS unsigned*)(lds + 32768);
    LAS float* scanw = (LAS float*)(lds + 41472);
    bf16x8 qf[4];
    { const GAS bf16_t* qp = Qp + (size_t)(qs + ql) * ldq + 8 * hi;
#pragma unroll
      for (int ks = 0; ks < 4; ++ks) qf[ks] = *(const GAS bf16x8*)(qp + 16 * ks); }
    const int kkey = tid >> 3, kc = tid & 7;
    const unsigned kst = (unsigned)(kkey * 128 + ((kc ^ ((kkey >> 1) & 7)) << 4));
    const int vkey = (tid >> 2) & 63, vc = (tid & 3) + 4 * (tid >> 8);
    const unsigned vst = (unsigned)((vc >> 2) * 4096 + vkey * 64 + (vc & 3) * 16);
    const GAS bf16_t* kg = Kp + (size_t)kkey * ldkv + kc * 8;
    const GAS bf16_t* vg = Vp + (size_t)vkey * ldkv + vc * 8;
    constexpr size_t tstep = (size_t)64 * ldkv;
    const GAS unsigned* selp = (MODE == 1) ? (seli + (size_t)(qs + ql) * 64) : nullptr;
    u32x4 krA, vrA, krB, vrB, k0s_, v0s_; u32x2 w2 = {0u, 0u}, wA = {0u, 0u}, wB = {0u, 0u};
    { const u32x4 k0_ = *(const GAS u32x4*)kg, v0_ = *(const GAS u32x4*)vg; if (MODE == 1) w2 = *(const GAS u32x2*)selp;
      krA = *(const GAS u32x4*)(kg + tstep); vrA = *(const GAS u32x4*)(vg + tstep); if (MODE == 1) wA = *(const GAS u32x2*)(selp + 2);
      krB = krA; vrB = vrA; wB = wA;
      if (NT > 2) { krB = *(const GAS u32x4*)(kg + 2 * tstep); vrB = *(const GAS u32x4*)(vg + 2 * tstep); if (MODE == 1) wB = *(const GAS u32x2*)(selp + 4); }
      k0s_ = k0_; v0s_ = v0_; }
    if (MODE == 0) {
        const int nq = q0 + 256; const int t4 = 4 * tid;
        f32x4 v = {0.f, 0.f, 0.f, 0.f}; if (t4 < nq) v = *(const GAS f32x4*)(lf + t4);
        const float a0 = v[0], a1 = a0 + v[1], a2 = a1 + v[2], a3 = a2 + v[3];
        float s = a3;
#pragma unroll
        for (int o = 1; o < 64; o <<= 1) { const float t = __shfl_up(s, o); if (lane >= o) s += t; }
        if (lane == 63) scanw[wid] = s;
        __syncthreads();
        float woff = 0.f;
#pragma unroll
        for (int w = 0; w < 8; ++w) { const float x = scanw[w]; if (w < wid) woff += x; }
        const float ex = woff + (s - a3);
        if (t4 < nq) *(LAS f32x4*)(cbias + t4) = (f32x4){ex + a0, ex + a1, ex + a2, ex + a3};
        __syncthreads();
        const float cref = cbias[q0];
        __syncthreads();
        if (t4 < nq) { const f32x4 c = *(LAS f32x4*)(cbias + t4); u32x4 w;
#pragma unroll
            for (int e = 0; e < 4; ++e) { const float b = cref - c[e]; const unsigned hb = pk2(b, 0.f) & 0xffffu; const float lo = b - __builtin_bit_cast(float, hb << 16); w[e] = hb | (pk2(lo, 0.f) << 16); }
            *(LAS u32x4*)(cbw + t4) = w; }
        if (tid < 64) cbw[2048 + tid] = 0u;
    }
    *(LAS u32x4*)(lds + kst) = k0s_; *(LAS u32x4*)(lds + 16384 + vst) = v0s_;
    __syncthreads();
    const unsigned kfb = (unsigned)(ql * 128); const int swz = (ql >> 1) & 7;
    const int bidx = hi ? 2048 : ql;
    const bf16x8 ones = __builtin_bit_cast(bf16x8, (u32x4){0x3f803f80u, 0u, 0u, 0u});
    float mhat = 0.f, lsum = 0.f; f32x16 ot[2]; ot[0] = (f32x16){}; ot[1] = (f32x16){};
    unsigned mhw = 0u;
    const unsigned one2 = hi ? 0u : 0x3f803f80u;
    const unsigned NEGB = __float_as_uint(NEGBIG);
#define FLASH_TILE(j, cur) do { \
        if (64 * (j) <= qs + 31) { \
            f32x16 p0, p1; \
            const LAS unsigned char* kb = lds + (cur) * 8192 + kfb; \
            bf16x8 k0[4], k1[4]; \
            _Pragma("unroll") for (int ks = 0; ks < 4; ++ks) { k0[ks] = *(const LAS bf16x8*)(kb + (((2 * ks + hi) ^ swz) << 4)); k1[ks] = *(const LAS bf16x8*)(kb + 4096 + (((2 * ks + hi) ^ swz) << 4)); } \
            if (MODE == 0) { \
                const unsigned b0 = cbw[(hi ? 0 : 64 * (j)) + bidx], b1 = cbw[(hi ? 0 : 64 * (j) + 32) + bidx]; \
                const bf16x8 xb = __builtin_bit_cast(bf16x8, (u32x4){0x3f803f80u, mhw, 0u, 0u}); \
                p0 = __builtin_amdgcn_mfma_f32_32x32x16_bf16(__builtin_bit_cast(bf16x8, (u32x4){b0, one2, 0u, 0u}), xb, (f32x16){}, 0, 0, 0); \
                p1 = __builtin_amdgcn_mfma_f32_32x32x16_bf16(__builtin_bit_cast(bf16x8, (u32x4){b1, one2, 0u, 0u}), xb, (f32x16){}, 0, 0, 0); \
            } else { \
                const bf16x8 xa = __builtin_bit_cast(bf16x8, (u32x4){one2, 0u, 0u, 0u}), xb = __builtin_bit_cast(bf16x8, (u32x4){mhw, 0u, 0u, 0u}); \
                p0 = __builtin_amdgcn_mfma_f32_32x32x16_bf16(xa, xb, (f32x16){}, 0, 0, 0); \
                p1 = __builtin_amdgcn_mfma_f32_32x32x16_bf16(xa, xb, (f32x16){}, 0, 0, 0); \
            } \
            _Pragma("unroll") for (int ks = 0; ks < 4; ++ks) { p0 = __builtin_amdgcn_mfma_f32_32x32x16_bf16(k0[ks], qf[ks], p0, 0, 0, 0); p1 = __builtin_amdgcn_mfma_f32_32x32x16_bf16(k1[ks], qf[ks], p1, 0, 0, 0); } \
            if (MODE == 1) { \
                const unsigned w0 = w2.x >> (4 * hi), w1 = w2.y >> (4 * hi); \
                _Pragma("unroll") for (int r = 0; r < 16; ++r) { const int bp = 8 * (r >> 2) + (r & 3); \
                    unsigned t0 = (unsigned)__builtin_amdgcn_sbfe((int)w0, bp, 1), t1 = (unsigned)__builtin_amdgcn_sbfe((int)w1, bp, 1);     \
                    asm("" : "+v"(t0), "+v"(t1));     \
                    const float s0 = p0[r], s1 = p1[r]; \
                    p0[r] = __uint_as_float((t0 & NEGB) | (~t0 & __float_as_uint(s0))); \
                    p1[r] = __uint_as_float((t1 & NEGB) | (~t1 & __float_as_uint(s1))); } \
            } \
            if (MODE == 0 && 64 * (j) + 63 > qs) { \
                const int qq = qs + ql; \
                _Pragma("unroll") for (int r = 0; r < 16; ++r) { const int key = 64 * (j) + crow(r, hi); if (key > qq) p0[r] = NEGBIG; if (key + 32 > qq) p1[r] = NEGBIG; } \
            } \
              \
            int mi = max(max(__float_as_int(p0[0]), __float_as_int(p1[0])), __float_as_int(p0[1])); \
            _Pragma("unroll") for (int r = 2; r < 16; r += 2) mi = max(max(mi, __float_as_int(p0[r])), __float_as_int(p0[r + 1])); \
            _Pragma("unroll") for (int r = 1; r < 15; r += 2) mi = max(max(mi, __float_as_int(p1[r])), __float_as_int(p1[r + 1])); \
            mi = max(mi, __float_as_int(p1[15])); \
            const float mx = xmax(fmaxf(__int_as_float(mi < 0 ? 0 : mi), 0.f)); \
            if (__builtin_expect(__any(mx > THR), 0)) { \
                const float mnew = mhat + mx; \
                const unsigned hb = pk2(mnew, 0.f) & 0xffffu; const float hf = __uint_as_float(hb << 16); \
                const unsigned lb = pk2(mnew - hf, 0.f) & 0xffffu; const float meff = hf + __uint_as_float(lb << 16); \
                const float dl = meff - mhat; mhat = meff; mhw = (hb | (lb << 16)) ^ 0x80008000u; \
                _Pragma("unroll") for (int r = 0; r < 16; ++r) { p0[r] -= dl; p1[r] -= dl; } \
                const float f = __builtin_amdgcn_exp2f(-dl); lsum *= f; \
                _Pragma("unroll") for (int r = 0; r < 16; ++r) { ot[0][r] *= f; ot[1][r] *= f; } \
            } \
            float ps0 = 0.f, ps1 = 0.f; \
            _Pragma("unroll") for (int r = 0; r < 16; ++r) { p0[r] = __builtin_amdgcn_exp2f(p0[r]); p1[r] = __builtin_amdgcn_exp2f(p1[r]); ps0 += p0[r]; ps1 += p1[r]; } \
            lsum += ps0 + ps1; \
            pv_tile(ot, p0, p1, lds + 16384 + (cur) * 8192, lane); \
        } } while (0)
    for (int j = 0; j < NT; j += 2) {
        FLASH_TILE(j, 0);
        *(LAS u32x4*)(lds + 8192 + kst) = krA; *(LAS u32x4*)(lds + 16384 + 8192 + vst) = vrA; w2 = wA;
        if (j + 3 < NT) { krA = *(const GAS u32x4*)(kg + (size_t)(j + 3) * tstep); vrA = *(const GAS u32x4*)(vg + (size_t)(j + 3) * tstep); if (MODE == 1) wA = *(const GAS u32x2*)(selp + 2 * (j + 3)); }
        __syncthreads();
        FLASH_TILE(j + 1, 1);
        if (j + 2 < NT) { *(LAS u32x4*)(lds + kst) = krB; *(LAS u32x4*)(lds + 16384 + vst) = vrB; w2 = wB; }
        if (j + 4 < NT) { krB = *(const GAS u32x4*)(kg + (size_t)(j + 4) * tstep); vrB = *(const GAS u32x4*)(vg + (size_t)(j + 4) * tstep); if (MODE == 1) wB = *(const GAS u32x2*)(selp + 2 * (j + 4)); }
        __syncthreads();
    }
#undef FLASH_TILE
    lsum = xsum(lsum);
    store_ot(ot, 1.0f / lsum, Op + (size_t)qs * ldo, ldo, lds + 49152 + wid * 4608, lane);
    __syncthreads();
}

__device__ __forceinline__ void sb_tile(f32x16& p0, f32x16& p1, float& Pr, int hi) {
    float og[8], tg[8];
#pragma unroll
    for (int kb = 0; kb < 2; ++kb)
#pragma unroll
        for (int g = 0; g < 4; ++g) {
            float b[4], om[4];
#pragma unroll
            for (int e = 0; e < 4; ++e) { const float z = kb ? p1[4 * g + e] : p0[4 * g + e];
                const float u = __builtin_amdgcn_exp2f(-fmaxf(z, -120.f)); b[e] = __builtin_amdgcn_rcpf(1.0f + u); om[e] = (z < -1.0e29f) ? 1.0f : u * b[e]; if (z < -1.0e29f) b[e] = 0.f; }
            const float e2 = om[3], e1 = e2 * om[2], e0 = e1 * om[1];
            og[4 * kb + g] = e0 * om[0];
            if (kb) { p1[4 * g + 0] = b[0] * e0; p1[4 * g + 1] = b[1] * e1; p1[4 * g + 2] = b[2] * e2; p1[4 * g + 3] = b[3]; }
            else    { p0[4 * g + 0] = b[0] * e0; p0[4 * g + 1] = b[1] * e1; p0[4 * g + 2] = b[2] * e2; p0[4 * g + 3] = b[3]; }
        }
#pragma unroll
    for (int i = 0; i < 8; ++i) tg[i] = __shfl_xor(og[i], 32);
    float suf = Pr;
#pragma unroll
    for (int i = 7; i >= 0; --i) {
        const float mul = suf * ((hi == 0) ? tg[i] : 1.0f);
        const int kb = i >> 2, g = i & 3;
#pragma unroll
        for (int e = 0; e < 4; ++e) { if (kb) p1[4 * g + e] *= mul; else p0[4 * g + e] *= mul; }
        suf *= og[i] * tg[i];
    }
    Pr = suf;
}
template <int ld, int ldo> __device__ __forceinline__ void sb_unit(LAS unsigned char* lds, const GAS bf16_t* Qp  , const GAS bf16_t* Kp, const GAS bf16_t* Vp, GAS bf16_t* Op, int qb) {
    const int tid = otid(), lane = tid & 63, wid = __builtin_amdgcn_readfirstlane(tid >> 6), ql = lane & 31, hi = lane >> 5;
    const int blk = (wid < 4) ? 2 * wid : 2 * (wid - 4) + 1;
    const int qs = qb * 256 + blk * 32, qq = qs + ql;
    LAS unsigned char* vimg = lds + wid * 8192;
    bf16x8 qf[4];
    { const GAS bf16_t* qp = Qp + (size_t)qq * ld + 8 * hi;
#pragma unroll
      for (int ks = 0; ks < 4; ++ks) qf[ks] = *(const GAS bf16x8*)(qp + 16 * ks); }
    f32x16 ot[2]; ot[0] = (f32x16){}; ot[1] = (f32x16){};
    float R = 1.f;
    const int vc = lane & 7;
    const unsigned vwo = (unsigned)((vc >> 2) * 4096 + (lane >> 3) * 64 + (vc & 3) * 16);
    bf16x8 kf[2][4]; u32x4 vv[8];
    { const int j = qs >> 6;
      const GAS bf16_t* kg = Kp + (size_t)(64 * j + ql) * ld + 8 * hi; const GAS bf16_t* vg = Vp + (size_t)(64 * j + (lane >> 3)) * ld + vc * 8;
#pragma unroll
      for (int ks = 0; ks < 4; ++ks) { kf[0][ks] = *(const GAS bf16x8*)(kg + 16 * ks); kf[1][ks] = *(const GAS bf16x8*)(kg + (size_t)32 * ld + 16 * ks); }
#pragma unroll
      for (int i = 0; i < 8; ++i) vv[i] = *(const GAS u32x4*)(vg + (size_t)(8 * i) * ld); }
    const int jd = qs >> 6;
    for (int j = jd; j >= 0; --j) {
#pragma unroll
        for (int i = 0; i < 8; ++i) *(LAS u32x4*)(vimg + vwo + i * 512) = vv[i];
        CFENCE();
        f32x16 p0 = (f32x16){}, p1 = (f32x16){};
#pragma unroll
        for (int ks = 0; ks < 4; ++ks) {
            p0 = __builtin_amdgcn_mfma_f32_32x32x16_bf16(kf[0][ks], qf[ks], p0, 0, 0, 0);
            p1 = __builtin_amdgcn_mfma_f32_32x32x16_bf16(kf[1][ks], qf[ks], p1, 0, 0, 0); }
        if (j > 0) {
            const GAS bf16_t* kg = Kp + (size_t)(64 * (j - 1) + ql) * ld + 8 * hi; const GAS bf16_t* vg = Vp + (size_t)(64 * (j - 1) + (lane >> 3)) * ld + vc * 8;
#pragma unroll
            for (int ks = 0; ks < 4; ++ks) { kf[0][ks] = *(const GAS bf16x8*)(kg + 16 * ks); kf[1][ks] = *(const GAS bf16x8*)(kg + (size_t)32 * ld + 16 * ks); }
#pragma unroll
            for (int i = 0; i < 8; ++i) vv[i] = *(const GAS u32x4*)(vg + (size_t)(8 * i) * ld);
        }
        if (j == jd) {
            const int kbase = 64 * j + 4 * hi;
#pragma unroll
            for (int r = 0; r < 16; ++r) { const int key = kbase + 8 * (r >> 2) + (r & 3); if (key >= qq) p0[r] = NEGBIG; if (key + 32 >= qq) p1[r] = NEGBIG; }
        }
        sb_tile(p0, p1, R, hi);
        pv_tile(ot, p0, p1, vimg, lane);
        CFENCE();
        if (__all(R < 1.0e-38f)) break;
    }
    store_ot(ot, 1.0f, Op + (size_t)qs * ldo, ldo, lds + 65536 + wid * 4608, lane);
}

__device__ __forceinline__ int count_ge4(unsigned a0, unsigned a1, unsigned a2, unsigned a3, unsigned cand) {
    unsigned long long m0, m1, m2, m3;
    asm volatile("v_cmp_ge_u32_e64 %0, %4, %8\n\tv_cmp_ge_u32_e64 %1, %5, %8\n\tv_cmp_ge_u32_e64 %2, %6, %8\n\tv_cmp_ge_u32_e64 %3, %7, %8"
                 : "=&s"(m0), "=&s"(m1), "=&s"(m2), "=&s"(m3) : "v"(a0), "v"(a1), "v"(a2), "v"(a3), "s"(cand));
    return (__builtin_popcountll(m0) + __builtin_popcountll(m1)) + (__builtin_popcountll(m2) + __builtin_popcountll(m3));
}

__device__ __forceinline__ void idx_tile(LAS unsigned char* lds, const GAS bf16_t* CBb  , const GAS bf16_t* KIb, const GAS float* WIb, GAS unsigned* SELb, int qt) {
    const int tid = otid(), lane = tid & 63, wid = __builtin_amdgcn_readfirstlane(tid >> 6);
    const int t0 = 16 * qt;
    LAS float* sc = (LAS float*)lds;
    if (t0 + 15 < 256) {
#pragma unroll
        for (int rr = 0; rr < 2; ++rr) { const int t = t0 + 2 * wid + rr; const int n = t + 1 - 32 * lane;
            const unsigned selm = (n >= 32) ? 0xffffffffu : ((n <= 0) ? 0u : ((1u << n) - 1u));
            SELb[(size_t)t * 64 + lane] = ~selm; }
        return;
    }
    const int nkt = qt + 1;
    {
        const int qi_ = lane & 15, kq = lane >> 4;
        bf16x8 qf[4][2];
        const GAS bf16_t* qp = CBb + (size_t)(t0 + qi_) * 1024 + 768 + 8 * kq;
#pragma unroll
        for (int h = 0; h < 4; ++h) { qf[h][0] = *(const GAS bf16x8*)(qp + h * 64); qf[h][1] = *(const GAS bf16x8*)(qp + h * 64 + 32); }
        const f32x4 wv = *(const GAS f32x4*)(WIb + (size_t)(t0 + qi_) * 4);
        for (int kt0 = wid; kt0 < nkt; kt0 += 32) {
            bf16x8 k0[4], k1[4];
#pragma unroll
            for (int u = 0; u < 4; ++u) { const int kt = kt0 + 8 * u; const int ktc = kt < nkt ? kt : 0;
                const GAS bf16_t* kp = KIb + (size_t)(16 * ktc + qi_) * 64 + 8 * kq; k0[u] = *(const GAS bf16x8*)kp; k1[u] = *(const GAS bf16x8*)(kp + 32); }
#pragma unroll
            for (int u = 0; u < 4; ++u) { const int kt = kt0 + 8 * u;
                if (kt < nkt) {
                    f32x4 s = {0.f, 0.f, 0.f, 0.f};
#pragma unroll
                    for (int h = 0; h < 4; ++h) { f32x4 d = {0.f, 0.f, 0.f, 0.f};
                        d = __builtin_amdgcn_mfma_f32_16x16x32_bf16(k0[u], qf[h][0], d, 0, 0, 0);
                        d = __builtin_amdgcn_mfma_f32_16x16x32_bf16(k1[u], qf[h][1], d, 0, 0, 0);
#pragma unroll
                        for (int e = 0; e < 4; ++e) s[e] += wv[h] * fmaxf(d[e], 0.f); }
                    *(LAS f32x4*)(sc + qi_ * 2052 + 16 * kt + 4 * kq) = s;
                } }
        }
    }
    __syncthreads();
    LAS unsigned* cbuf = (LAS unsigned*)(lds + 131328 + wid * 256);
#pragma unroll 1
    for (int rr = 0; rr < 2; ++rr) {
        const int q = 2 * wid + rr, t = t0 + q;
        const int ng = (t >> 8) + 1;
        unsigned u[32];
#pragma unroll
        for (int g = 0; g < 8; ++g) {
            if (g < ng) {
#pragma unroll
                for (int k = 0; k < 4; ++k) { const int i = 4 * g + k; const int s = 64 * i + lane; const unsigned b = __float_as_uint(sc[q * 2052 + s]);
                    const unsigned key = (b & 0x80000000u) ? ~b : (b | 0x80000000u); u[i] = (s <= t) ? key : 0u; }
            } else {
#pragma unroll
                for (int k = 0; k < 4; ++k) u[4 * g + k] = 0u;
            }
        }
        unsigned T = 0u; int exact = 0, n_ge = 256 * ng, n_hi = 0, bit = 31;
#pragma unroll 1
        for (; bit >= 0; --bit) {
            if (n_ge - n_hi <= 64) break;
            const unsigned cand = T | (1u << bit); int cnt = 0;
#pragma unroll
            for (int g = 0; g < 8; ++g) if (g < ng) cnt += count_ge4(u[4 * g], u[4 * g + 1], u[4 * g + 2], u[4 * g + 3], cand);
            if (cnt >= 256) { T = cand; n_ge = cnt; } else n_hi = cnt;
            if (cnt == 256) { exact = 1; break; }
        }
        if (!exact && bit >= 0) {
            const unsigned range = 2u << bit; int base = 0;
#pragma unroll
            for (int g = 0; g < 8; ++g) if (g < ng) {
#pragma unroll
                for (int k = 0; k < 4; ++k) { const int i = 4 * g + k; const bool act = (u[i] - T) < range; const unsigned long long m = __ballot(act);
                    const int pos = base + (int)__builtin_amdgcn_mbcnt_hi((unsigned)(m >> 32), __builtin_amdgcn_mbcnt_lo((unsigned)m, 0u));
                    if (act) cbuf[pos] = u[i]; base += __builtin_popcountll(m); } }
            CFENCE();
            const unsigned a = (lane < base) ? cbuf[lane] : 0u;
            CFENCE();
#pragma unroll 1
            for (; bit >= 0; --bit) {
                const unsigned cand = T | (1u << bit);
                const int cnt = n_hi + __builtin_popcountll(__ballot(a >= cand));
                if (cnt >= 256) T = cand;
                if (cnt == 256) { exact = 1; break; }
            }
        }
        asm volatile("" : "+s"(T), "+s"(exact));
        int need = 0;
        if (!exact) { int cgt = 0;
#pragma unroll
            for (int g = 0; g < 8; ++g) if (g < ng) {
#pragma unroll
                for (int k = 0; k < 4; ++k) cgt += __builtin_popcountll(__ballot(u[4 * g + k] > T)); }
            need = 256 - cgt; }
        unsigned word = 0xffffffffu; int cum = 0;
#pragma unroll
        for (int g = 0; g < 8; ++g) if (g < ng) {
#pragma unroll
            for (int k = 0; k < 4; ++k) { const int i = 4 * g + k;
                bool sel;
                if (exact) sel = (u[i] >= T);
                else { const bool eq = (u[i] == T); const unsigned long long em = __ballot(eq);
                    const int rank = (int)__builtin_amdgcn_mbcnt_hi((unsigned)(em >> 32), __builtin_amdgcn_mbcnt_lo((unsigned)em, 0u));
                    sel = (u[i] > T) || (eq && (cum + rank < need)); cum += __builtin_popcountll(em); }
                const unsigned long long sm = ~__ballot(sel);
                if ((lane >> 1) == i) word = (lane & 1) ? (unsigned)(sm >> 32) : (unsigned)sm; } }
        SELb[(size_t)t * 64 + lane] = word;
    }
    __syncthreads();
}
}

__device__ __forceinline__ float wave_sum(float v) {
#pragma unroll
    for (int o = 1; o < 64; o <<= 1) v += __shfl_xor(v, o);
    return v;
}
__device__ __forceinline__ int small_src(int j) { return j < 64 ? 4104 + j : (j < 72 ? 3072 + (j - 64) : (j < 76 ? 4168 + (j - 72) : -1)); }
__device__ __forceinline__ void tp_item(const GAS float* W, int ldsrc, int K, int k0, int src_col0, int small_j0, const GAS float* gain, GAS bf16_t* WT, int dst_row0, LAS float* scr, int lane) {
    const int nn = lane & 31; const int scol = (src_col0 >= 0) ? (src_col0 + nn) : small_src(small_j0 + nn);
#pragma unroll 8
    for (int i = 0; i < 32; ++i) { const int kk = 2 * i + (lane >> 5); float v = 0.f; if (scol >= 0) v = W[(size_t)(k0 + kk) * ldsrc + scol]; if (gain) v *= gain[k0 + kk]; scr[kk * 33 + nn] = v; }
    asm volatile("s_waitcnt lgkmcnt(0)" ::: "memory");
    const int c = lane & 7;
#pragma unroll
    for (int j = 0; j < 4; ++j) { const int n = (lane >> 3) + 8 * j; const LAS float* s = scr + (8 * c) * 33 + n;
        u32x4 o; o.x = pk2(s[0 * 33], s[1 * 33]); o.y = pk2(s[2 * 33], s[3 * 33]); o.z = pk2(s[4 * 33], s[5 * 33]); o.w = pk2(s[6 * 33], s[7 * 33]);
        *(GAS u32x4*)(WT + (size_t)(dst_row0 + n) * K + k0 + 8 * c) = o; }
    asm volatile("s_waitcnt lgkmcnt(0)" ::: "memory");
}
__device__ __forceinline__ void tp_item64(const GAS float* W, int ldsrc, int K, int k0, int src_col0, const GAS float* gain, GAS bf16_t* WT, int dst_row0, LAS float* scr, int lane) {
    const int c4 = lane & 15, kr = lane >> 4;
    f32x4 v[16];
#pragma unroll
    for (int i = 0; i < 16; ++i) v[i] = *(const GAS f32x4*)(W + (size_t)(k0 + 4 * i + kr) * ldsrc + src_col0 + 4 * c4);
#pragma unroll
    for (int i = 0; i < 16; ++i) { LAS float* d = scr + (4 * i + kr) * 65 + 4 * c4; d[0] = v[i][0]; d[1] = v[i][1]; d[2] = v[i][2]; d[3] = v[i][3]; }
    asm volatile("s_waitcnt lgkmcnt(0)" ::: "memory");
    const int c = lane & 7;
    f32x4 g0 = {1.f, 1.f, 1.f, 1.f}, g1 = g0;
    if (gain) { g0 = *(const GAS f32x4*)(gain + k0 + 8 * c); g1 = *(const GAS f32x4*)(gain + k0 + 8 * c + 4); }
#pragma unroll
    for (int j = 0; j < 8; ++j) { const int n = (lane >> 3) + 8 * j; const LAS float* s = scr + (8 * c) * 65 + n;
        u32x4 o; o.x = pk2(s[0 * 65] * g0[0], s[1 * 65] * g0[1]); o.y = pk2(s[2 * 65] * g0[2], s[3 * 65] * g0[3]); o.z = pk2(s[4 * 65] * g1[0], s[5 * 65] * g1[1]); o.w = pk2(s[6 * 65] * g1[2], s[7 * 65] * g1[3]);
        *(GAS u32x4*)(WT + (size_t)(dst_row0 + n) * K + k0 + 8 * c) = o; }
    asm volatile("s_waitcnt lgkmcnt(0)" ::: "memory");
}

struct Args { const float* in[11]; const int* pos; float* out; unsigned char* ws; int ph_lo, ph_hi; };
constexpr int N_PHASES = 24;
#ifndef PH_INLINE
#define PH_INLINE __forceinline__
#endif

__device__ PH_INLINE void ph_prep(LAS unsigned char* lds, unsigned char* ws, const float* w_in_, const float* g_mix_, const float* w_br_, const float* w_out_, const float* g_mlp_, const float* w_up_, const float* w_dn_, const int* pos_) {
    ws = optr(ws);
    const GAS float* w_in = (const GAS float*)w_in_; const GAS float* g_mix = (const GAS float*)g_mix_; const GAS float* w_br = (const GAS float*)w_br_; const GAS float* w_out = (const GAS float*)w_out_;
    const GAS float* g_mlp = (const GAS float*)g_mlp_; const GAS float* w_up = (const GAS float*)w_up_; const GAS float* w_dn = (const GAS float*)w_dn_; const GAS int* pos = (const GAS int*)pos_;
    const int tid = otid(), lane = tid & 63, wave = __builtin_amdgcn_readfirstlane(tid >> 6);
    const int G = gridDim.x, bx = blockIdx.x, gw = bx * NWAVES + wave, NGW = G * NWAVES;
    GAS float* CS = (GAS float*)(ws + WS_CS);
    LAS float* scr = (LAS float*)(lds + wave * 17408);
    constexpr int I_IN = 16 * 112, I_SM = 16 * 8, I_BR = 3 * 8 * 16, I_OUT = 16 * 16, I_UP = 16 * 64, I_DN = 64 * 16, I_L = I_IN + I_SM + I_BR + I_OUT + I_UP + I_DN;
    for (int it = gw; it < 2 * I_L; it += NGW) {
        const int l = it / I_L; int r = it - l * I_L;
        GAS unsigned char* wl = (GAS unsigned char*)(ws + WS_W + (size_t)l * W_LAYER);
        if (r < I_IN) { const int kb = r / 112, nb = r % 112, row = 64 * nb; int src;
            if (row < 3072) src = row; else if (row < 3584) src = 3080 + (row - 3072); else if (row < 3712) src = 3592 + (row - 3584); else if (row < 3840) src = 3720 + (row - 3712);
            else if (row < 4096) src = 3848 + (row - 3840); else src = 4172 + (row - 4096);
            tp_item64(w_in + (size_t)l * DM * COLT, COLT, DM, 64 * kb, src, g_mix + l * DM, (GAS bf16_t*)(wl + W_IN), row, scr, lane); continue; }
        r -= I_IN;
        if (r < I_SM) { const int kb = r / 8, nb = r % 8;
            tp_item(w_in + (size_t)l * DM * COLT, COLT, DM, 64 * kb, -1, 32 * nb, g_mix + l * DM, (GAS bf16_t*)(wl + W_IN), 7168 + 32 * nb, scr, lane); continue; }
        r -= I_SM;
        if (r < I_BR) { const int b = r / 128, r2 = r % 128, kb = r2 / 16, nb = r2 % 16;
            tp_item64(w_br + ((size_t)l * 3 + b) * 512 * DM, DM, 512, 64 * kb, 64 * nb, nullptr, (GAS bf16_t*)(wl + W_BR) + (size_t)b * DM * 512, 64 * nb, scr, lane); continue; }
        r -= I_BR;
        if (r < I_OUT) { const int kb = r / 16, nb = r % 16;
            tp_item64(w_out + (size_t)l * DM * DM, DM, DM, 64 * kb, 64 * nb, nullptr, (GAS bf16_t*)(wl + W_OUT), 64 * nb, scr, lane); continue; }
        r -= I_OUT;
        if (r < I_UP) { const int kb = r / 64, nb = r % 64;
            tp_item64(w_up + (size_t)l * DM * FF, FF, DM, 64 * kb, 64 * nb, g_mlp + l * DM, (GAS bf16_t*)(wl + W_UP), 64 * nb, scr, lane); continue; }
        r -= I_UP;
        { const int kb = r / 16, nb = r % 16;
            tp_item64(w_dn + (size_t)l * FF * DM, DM, FF, 64 * kb, 64 * nb, nullptr, (GAS bf16_t*)(wl + W_DN), 64 * nb, scr, lane); }
    }
    for (int i = bx * (NWAVES * 64) + tid; i < MTOK * 8; i += G * NWAVES * 64) {
        const int tok = i >> 3, f = i & 7;
        const float invf = (f == 0) ? 1.0f : (f == 1) ? 0.1939227432012558f : (f == 2) ? 0.03760603070259094f : (f == 3) ? 0.007292664609849453f : (f == 4) ? 0.0014142135623842478f
                          : (f == 5) ? 0.00027424818836152554f : (f == 6) ? 5.318296098266728e-05f : 1.0313386155758053e-05f;
        const float ang = (float)pos[tok] * invf;
        CS[(size_t)tok * 16 + f] = cosf(ang); CS[(size_t)tok * 16 + 8 + f] = sinf(ang);
    }
}
__device__ PH_INLINE void ph_xprep(unsigned char* ws, const float* xcur_) {
    ws = optr(ws);
    const GAS float* xcur = (const GAS float*)xcur_;
    const int tid = otid(), lane = tid & 63, wave = __builtin_amdgcn_readfirstlane(tid >> 6);
    const int gw = blockIdx.x * NWAVES + wave, NGW = gridDim.x * NWAVES;
    GAS bf16_t* XB = (GAS bf16_t*)(ws + WS_XB); GAS bf16_t* XL = (GAS bf16_t*)(ws + WS_XL); GAS float* SS0 = (GAS float*)(ws + WS_CTL + SS_OFF);
    for (int m = gw; m < MTOK; m += NGW) {
        const GAS f32x4* xr = (const GAS f32x4*)(xcur + (size_t)m * DM) + lane; f32x4 v[4]; float s = 0.f;
#pragma unroll
        for (int j = 0; j < 4; ++j) { v[j] = xr[64 * j]; s += (v[j][0] * v[j][0] + v[j][1] * v[j][1]) + (v[j][2] * v[j][2] + v[j][3] * v[j][3]); }
        s = wave_sum(s);
        if (lane == 0) SS0[m] = s;
        GAS u32x2* o8 = (GAS u32x2*)(XB + (size_t)m * DM) + lane; GAS u32x2* l8 = (GAS u32x2*)(XL + (size_t)m * DM) + lane;
#pragma unroll
        for (int j = 0; j < 4; ++j) { u32x2 w; w.x = pk2(v[j][0], v[j][1]); w.y = pk2(v[j][2], v[j][3]); o8[64 * j] = w;
            u32x2 lw; lw.x = pk2(v[j][0] - __uint_as_float(w.x << 16), v[j][1] - __uint_as_float(w.x & 0xffff0000u)); lw.y = pk2(v[j][2] - __uint_as_float(w.y << 16), v[j][3] - __uint_as_float(w.y & 0xffff0000u)); l8[64 * j] = lw; }
    }
}
__device__ __forceinline__ void inproj_tail(LAS unsigned char* lds, unsigned char* ws, unsigned char* wl, bf16_t* XB, const GAS float* SS, const float* bfg_, int tok0) {
    const int G = gridDim.x, bx = blockIdx.x;
    const int tid = otid(), lane = tid & 63, wid = __builtin_amdgcn_readfirstlane(tid >> 6), rg = wid & 3, kh = wid >> 2, tl = lane & 15, g4 = lane >> 4;
    const GAS float* bfg = (const GAS float*)bfg_;
    const GAS float* CS = (const GAS float*)(ws + WS_CS);
    GAS bf16_t* KI = (GAS bf16_t*)(ws + WS_KI); GAS float* WI = (GAS float*)(ws + WS_WI); GAS float* LF = (GAS float*)(ws + WS_LF);
    LAS f32x4* xch = (LAS f32x4*)lds;
    for (int grp = bx; grp < MH / 64; grp += G) {
        const int row = grp * 64 + rg * 16 + tl;
        const GAS bf16_t* xp = (const GAS bf16_t*)XB + (size_t)(tok0 + row) * DM + kh * 512 + 8 * g4;
        const GAS bf16_t* wp = (const GAS bf16_t*)(wl + W_IN) + (size_t)(7168 + tl) * DM + kh * 512 + 8 * g4;
        f32x4 acc[5];
#pragma unroll
        for (int nt = 0; nt < 5; ++nt) acc[nt] = (f32x4){0.f, 0.f, 0.f, 0.f};
#pragma unroll 1
        for (int kb = 0; kb < 16; kb += 4) {
            bf16x8 xf[4], wf[4][5];
#pragma unroll
            for (int u = 0; u < 4; ++u) { xf[u] = *(const GAS bf16x8*)(xp + 32 * (kb + u));
#pragma unroll
                for (int nt = 0; nt < 5; ++nt) wf[u][nt] = *(const GAS bf16x8*)(wp + (size_t)(16 * nt) * DM + 32 * (kb + u)); }
#pragma unroll
            for (int u = 0; u < 4; ++u)
#pragma unroll
                for (int nt = 0; nt < 5; ++nt) acc[nt] = __builtin_amdgcn_mfma_f32_16x16x32_bf16(wf[u][nt], xf[u], acc[nt], 0, 0, 0);
        }
        if (kh == 1) {
#pragma unroll
            for (int nt = 0; nt < 5; ++nt) xch[(rg * 5 + nt) * 64 + lane] = acc[nt];
        }
        __syncthreads();
        if (kh == 0) {
            const float rs = pg8::rs_of(SS[tok0 + row]);
#pragma unroll
            for (int nt = 0; nt < 5; ++nt) acc[nt] = (acc[nt] + xch[(rg * 5 + nt) * 64 + lane]) * rs;
            { const f32x4 cs = *(const GAS f32x4*)(CS + (size_t)(tok0 + row) * 16 + 4 * (g4 & 1)), sn = *(const GAS f32x4*)(CS + (size_t)(tok0 + row) * 16 + 8 + 4 * (g4 & 1));
              const float sg = (g4 < 2) ? -1.f : 1.f; f32x4 v = acc[0];
#pragma unroll
              for (int e = 0; e < 4; ++e) { const float p = __shfl_xor(v[e], 32); v[e] = v[e] * cs[e] + sg * p * sn[e]; }
              acc[0] = v; }
#pragma unroll
            for (int nt = 0; nt < 4; ++nt) { u32x2 w; w.x = pk2(acc[nt][0], acc[nt][1]); w.y = pk2(acc[nt][2], acc[nt][3]); *(GAS u32x2*)(KI + (size_t)row * 64 + 16 * nt + 4 * g4) = w; }
            if (g4 < 2) { const int bl = row >> 11, t = row & 2047; GAS float* lp = LF + ((size_t)bl * 8 + 4 * g4) * SEQ + t;
#pragma unroll
                for (int e = 0; e < 4; ++e) lp[(size_t)e * SEQ] = pg8::logsigmoidf_(acc[4][e] + bfg[4 * g4 + e]) * LOG2E; }
            else if (g4 == 2) *(GAS f32x4*)(WI + (size_t)row * 4) = acc[4] * 0.5f;
        }
        __syncthreads();
    }
}
__device__ PH_INLINE void ph_inproj(LAS unsigned char* lds, unsigned char* ws, const float* bfg_, int l, int hf) {
    ws = optr(ws);
    const int G = gridDim.x, bx = blockIdx.x; const int tok0 = hf * MH;
    unsigned char* wl = ws + WS_W + (size_t)l * W_LAYER;
    bf16_t* XB = (bf16_t*)(ws + WS_XB);
    const GAS float* SS = (const GAS float*)(ws + WS_CTL + SS_OFF + (size_t)(2 * l) * SS_STRIDE);
    const bool tail_first = (bx & 1) != 0;
    if (tail_first) inproj_tail(lds, ws, wl, XB, SS, bfg_, tok0);
    {
        pg8::TileOrder<MH / 256, 28, 1, DM, DM, 0, 0, 0> S; S.G = G; S.c = bx;
        S.A = (const char*)(XB + (size_t)tok0 * DM); S.B = (const char*)(wl + W_IN);
        pg8::EpiInProj E{(GAS bf16_t*)(ws + WS_QKV), (GAS bf16_t*)(ws + WS_CB), (GAS unsigned char*)(ws + WS_G), (GAS bf16_t*)(ws + WS_KI), (GAS float*)(ws + WS_WI), (GAS float*)(ws + WS_LF), SS, (const GAS float*)(ws + WS_CS), (const GAS float*)bfg_, tok0};
        pg8::gemm_phase<DM, DM, DM>(lds, S, E);
    }
    if (!tail_first) inproj_tail(lds, ws, wl, XB, SS, bfg_, tok0);
}
template <int UMASK, bool DUMMY>
__device__ PH_INLINE void ph_att1(LAS unsigned char* lds, unsigned char* ws, unsigned* qctr, int tok0) {
    volatile LAS unsigned* MISC = (volatile LAS unsigned*)(lds + MISC_OFF);
    const int tid = otid(); ws = optr(ws);
    GAS bf16_t* QKV = (GAS bf16_t*)(ws + WS_QKV); GAS bf16_t* CB = (GAS bf16_t*)(ws + WS_CB); GAS bf16_t* KI = (GAS bf16_t*)(ws + WS_KI); GAS float* WI = (GAS float*)(ws + WS_WI); GAS float* LF = (GAS float*)(ws + WS_LF); GAS unsigned* SEL = (GAS unsigned*)(ws + WS_SEL);
    GAS bf16_t* YD = (GAS bf16_t*)(ws + WS_Y) + (size_t)tok0 * 1024;
    for (;;) {
        if (tid == 0) MISC[0] = __hip_atomic_fetch_add(qctr, 1u, __ATOMIC_RELAXED, __HIP_MEMORY_SCOPE_AGENT);
        __syncthreads();
        const int ui = (int)MISC[0];
        __syncthreads();
        if (ui >= 512 + 2048) break;
        if (ui < 512) { if (UMASK & 1) { const int qb = 7 - (ui >> 6), bh = ui & 63, bl = bh >> 3, h = bh & 7;
            GAS bf16_t* base = QKV + (size_t)bl * SEQ * 3072 + h * 64;
            if (DUMMY) att::flash_unit<0, 3072, 3072, 1024>(lds, base + 1536, base + 2048, base + 2560, YD + (size_t)bl * SEQ * 1024 + 512 + h * 64, qb, LF + (size_t)(bl * 8 + h) * SEQ, nullptr);
            else att::flash_unit<0, 3072, 3072, 3072>(lds, base + 1536, base + 2048, base + 2560, base + 1536, qb, LF + (size_t)(bl * 8 + h) * SEQ, nullptr); }
        } else if ((ui & 3) != 3) { if (UMASK & 2) { const int i = ((ui - 512) >> 2) * 3 + (ui & 3), qt = 127 - (i >> 3), bl = i & 7;
            if (qt >= 0) att::idx_tile(lds, CB + (size_t)bl * SEQ * 1024, KI + (size_t)bl * SEQ * 64, WI + (size_t)bl * SEQ * 4, SEL + (size_t)bl * SEQ * 64, qt); }
        } else { if (UMASK & 4) { const int i = (ui - 512) >> 2, qb = 7 - (i >> 6), bh = i & 63, bl = bh >> 3, h = bh & 7;
            GAS bf16_t* base = QKV + (size_t)bl * SEQ * 3072 + h * 64;
            if (DUMMY) att::sb_unit<3072, 1024>(lds, base, base + 512, base + 1024, YD + (size_t)bl * SEQ * 1024 + h * 64, qb);
            else att::sb_unit<3072, 3072>(lds, base, base + 512, base + 1024, base, qb);
            __syncthreads(); }
        }
    }
}
__device__ PH_INLINE void ph_att2(LAS unsigned char* lds, unsigned char* ws, unsigned* qctr) {
    volatile LAS unsigned* MISC = (volatile LAS unsigned*)(lds + MISC_OFF);
    const int tid = otid(); ws = optr(ws);
    GAS bf16_t* QKV = (GAS bf16_t*)(ws + WS_QKV); GAS bf16_t* CB = (GAS bf16_t*)(ws + WS_CB); GAS unsigned* SEL = (GAS unsigned*)(ws + WS_SEL);
    const int G = gridDim.x, bx = blockIdx.x;
    if (G == 256) {
        const int vcu = (bx & 7) * 32 + (bx >> 3);
        const int bh = vcu >> 2, sp = vcu & 3, bl = bh >> 3, h = bh & 7;
        const GAS bf16_t* cb = CB + (size_t)bl * SEQ * 1024;
#pragma unroll 1
        for (int i = 0; i < 2; ++i) { const int qb = i ? sp : 7 - sp;
            att::flash_unit<1, 1024, 1024, 3072>(lds, cb + h * 64, cb + 512 + (h >> 2) * 64, cb + 640 + (h >> 2) * 64, QKV + (size_t)bl * SEQ * 3072 + 512 + h * 64, qb, nullptr, SEL + (size_t)bl * SEQ * 64); }
        return;
    }
    for (;;) {
        if (tid == 0) MISC[0] = __hip_atomic_fetch_add(qctr, 1u, __ATOMIC_RELAXED, __HIP_MEMORY_SCOPE_AGENT);
        __syncthreads();
        const int ui = (int)MISC[0];
        __syncthreads();
        if (ui >= 512) break;
        const int qb = 7 - (ui >> 6), bh = ui & 63, bl = bh >> 3, h = bh & 7;
        const GAS bf16_t* cb = CB + (size_t)bl * SEQ * 1024;
        att::flash_unit<1, 1024, 1024, 3072>(lds, cb + h * 64, cb + 512 + (h >> 2) * 64, cb + 640 + (h >> 2) * 64, QKV + (size_t)bl * SEQ * 3072 + 512 + h * 64, qb, nullptr, SEL + (size_t)bl * SEQ * 64);
    }
}
__device__ PH_INLINE void ph_branch(LAS unsigned char* lds, unsigned char* ws, int l, int hf) {
    ws = optr(ws);
    const int G = gridDim.x, bx = blockIdx.x; const int tok0 = hf * MH;
    unsigned char* wl = ws + WS_W + (size_t)l * W_LAYER;
    pg8::TileOrder<MH / 256, 4, 3, 3072, 512, DM * 512, 1536 * 2, 512 * 2> S; S.G = G; S.c = bx;
    S.A = (const char*)(ws + WS_QKV); S.B = (const char*)(wl + W_BR);
    pg8::EpiBranch E{(const GAS unsigned char*)(ws + WS_G), (GAS bf16_t*)(ws + WS_Y), tok0};
    pg8::gemm_phase<512, 3072, 512>(lds, S, E);
}
__device__ PH_INLINE void ph_outproj(LAS unsigned char* lds, unsigned char* ws, int l, const float* xin, float* xout) {
    ws = optr(ws);
    const int G = gridDim.x, bx = blockIdx.x;
    unsigned char* wl = ws + WS_W + (size_t)l * W_LAYER;
    pg8::TileOrder<MTOK / 256, 4, 1, DM, DM, 0, 0, 0> S; S.G = G; S.c = bx;
    S.A = (const char*)(ws + WS_Y); S.B = (const char*)(wl + W_OUT);
    pg8::EpiResid E{(GAS bf16_t*)(ws + WS_XB), (GAS bf16_t*)(ws + WS_XL), (GAS float*)(ws + WS_CTL + SS_OFF + (size_t)(2 * l + 1) * SS_STRIDE)};
    pg8::gemm_phase<DM, DM, DM>(lds, S, E);
}
__device__ PH_INLINE void ph_up(LAS unsigned char* lds, unsigned char* ws, int l) {
    ws = optr(ws);
    const int G = gridDim.x, bx = blockIdx.x;
    unsigned char* wl = ws + WS_W + (size_t)l * W_LAYER;
    pg8::TileOrder<MTOK / 256, FF / 256, 1, DM, DM, 0, 0, 0> S; S.G = G; S.c = bx;
    S.A = (const char*)(ws + WS_XB); S.B = (const char*)(wl + W_UP);
    pg8::EpiUp E{(GAS bf16_t*)(ws + WS_HID), (const GAS float*)(ws + WS_CTL + SS_OFF + (size_t)(2 * l + 1) * SS_STRIDE)};
    pg8::gemm_phase<DM, DM, DM>(lds, S, E);
}
__device__ PH_INLINE void ph_down(LAS unsigned char* lds, unsigned char* ws, int l, float* xs) {
    ws = optr(ws);
    const int G = gridDim.x, bx = blockIdx.x;
    unsigned char* wl = ws + WS_W + (size_t)l * W_LAYER;
    pg8::TileOrder<MTOK / 256, 4, 1, FF, FF, 0, 0, 0> S; S.G = G; S.c = bx;
    S.A = (const char*)(ws + WS_HID); S.B = (const char*)(wl + W_DN);
    pg8::EpiResid E{(GAS bf16_t*)(ws + WS_XB), (GAS bf16_t*)(ws + WS_XL), (GAS float*)(ws + WS_CTL + SS_OFF + (size_t)(2 * l + 2) * SS_STRIDE)};
    pg8::gemm_phase<FF, FF, FF>(lds, S, E);
}
__device__ PH_INLINE void ph_final(unsigned char* ws, float* out_, const float* gfin_) {
    GAS float* out = (GAS float*)out_; const GAS float* gfin = (const GAS float*)gfin_;
    const GAS float* SS = (const GAS float*)(ws + WS_CTL + SS_OFF + 4 * SS_STRIDE);
    const GAS bf16_t* XB = (const GAS bf16_t*)(ws + WS_XB); const GAS bf16_t* XL = (const GAS bf16_t*)(ws + WS_XL);
    const int tid = otid(), lane = tid & 63, wave = __builtin_amdgcn_readfirstlane(tid >> 6);
    const int gw = blockIdx.x * NWAVES + wave, NGW = gridDim.x * NWAVES;
    f32x4 g[4];
#pragma unroll
    for (int j = 0; j < 4; ++j) g[j] = ((const GAS f32x4*)gfin)[64 * j + lane];
    for (int m = gw; m < MTOK; m += NGW) {
        GAS f32x4* orow = (GAS f32x4*)(out + (size_t)m * DM) + lane;
        const GAS u32x2* hr = (const GAS u32x2*)(XB + (size_t)m * DM) + lane; const GAS u32x2* lr = (const GAS u32x2*)(XL + (size_t)m * DM) + lane;
        const float rs = pg8::rs_of(SS[m]);
#pragma unroll
        for (int j = 0; j < 4; ++j) { const u32x2 h = hr[64 * j], l = lr[64 * j];
            const f32x4 x = {__uint_as_float(h.x << 16) + __uint_as_float(l.x << 16), __uint_as_float(h.x & 0xffff0000u) + __uint_as_float(l.x & 0xffff0000u),
                             __uint_as_float(h.y << 16) + __uint_as_float(l.y << 16), __uint_as_float(h.y & 0xffff0000u) + __uint_as_float(l.y & 0xffff0000u)};
            orow[64 * j] = x * rs * g[j]; }
    }
}

template <int PHM> __global__ void __launch_bounds__(NWAVES * 64, 2) trunk_fwd(Args args) {
    extern __shared__ __attribute__((aligned(16))) unsigned char lds_raw[];
    LAS unsigned char* lds = (LAS unsigned char*)lds_raw;
    volatile LAS unsigned* MISC = (volatile LAS unsigned*)(lds + MISC_OFF);
    unsigned char* ws = args.ws;
    unsigned* ctl = (unsigned*)(ws + WS_CTL);
    float* xs = args.out;
    if (threadIdx.x < 64) MISC[threadIdx.x] = 0u;
    __syncthreads();
    const int lo = args.ph_lo, hi = args.ph_hi;
    XcdBarrier bar; bar.bar = ctl + CW_BAR; bar.x = 0; bar.st = nullptr;
    if (hi - lo > 1) bar = xcd_barrier_post(ctl + CW_BAR, MISC + 8);
#define SITE(n) (((PHM) >> (n)) & 1)
#define IN(k) (lo <= (k) && (k) < hi)
#define SEAM(k) do { if ((k) + 1 < hi) xcd_barrier(bar); } while (0)
#define DUP(n) (((PROBE_DUP) >> (n)) & 1)
    int k = 0;
    if (SITE(0) && IN(k)) { ph_prep(lds, ws, args.in[3], args.in[2], args.in[5], args.in[6], args.in[7], args.in[8], args.in[9], args.pos); ph_xprep(ws, args.in[0]);
        if (DUP(0)) { xcd_barrier(bar); ph_prep(lds, ws, args.in[3], args.in[2], args.in[5], args.in[6], args.in[7], args.in[8], args.in[9], args.pos); ph_xprep(ws, args.in[0]); } SEAM(k); }
    ++k;
    for (int l = 0; l < 2; ++l) {
        const float* xcur = (l == 0) ? args.in[0] : xs;
        for (int hf = 0; hf < 2; ++hf) {
            if (SITE(2) && IN(k)) { ph_inproj(lds, ws, args.in[4] + l * 8, l, hf); SEAM(k); }
            ++k;
            if (SITE(3) && IN(k)) {
#if PROBE_ATT1
                ph_att1<PROBE_ATT1, true>(lds, ws, ctl + CW_Q + 64 * (16 + (l * 2 + hf) * 2 + 0), hf * MH); xcd_barrier(bar);
#endif
                ph_att1<7, false>(lds, ws, ctl + CW_Q + 64 * ((l * 2 + hf) * 2 + 0), hf * MH); SEAM(k); }
            ++k;
            if (SITE(4) && IN(k)) { ph_att2(lds, ws, ctl + CW_Q + 64 * ((l * 2 + hf) * 2 + 1)); SEAM(k); }
            ++k;
            if (SITE(5) && IN(k)) { ph_branch(lds, ws, l, hf); if (DUP(5)) { xcd_barrier(bar); ph_branch(lds, ws, l, hf); } SEAM(k); }
            ++k;
        }
        if (SITE(6) && IN(k)) { ph_outproj(lds, ws, l, xcur, xs); SEAM(k); }
        ++k;
        if (SITE(8) && IN(k)) { ph_up(lds, ws, l); SEAM(k); }
        ++k;
        if (SITE(9) && IN(k)) { ph_down(lds, ws, l, xs); SEAM(k); }
        ++k;
    }
    if (SITE(10) && IN(k)) ph_final(ws, xs, args.in[10]);
#undef IN
#undef SEAM
#undef SITE
}

static int site_of_phase(int p) {
    if (p == 0) return 0; if (p == N_PHASES - 1) return 10;
    const int q = (p - 1) % 11;
    if (q < 8) return 2 + (q & 3); if (q == 8) return 6; if (q == 9) return 8; return 9;
}
typedef void (*kern_t)(Args);
extern "C" void kernel_launch(void* const* d_in, const int* in_sizes, int n_in, void* d_out, int out_size, void* d_ws, size_t ws_size, hipStream_t stream) {
    static int grid = 0;
#if MK_ONE_LAUNCH
    static const kern_t kerns[11] = {trunk_fwd<0x7ff>, trunk_fwd<0x7ff>, trunk_fwd<0x7ff>, trunk_fwd<0x7ff>, trunk_fwd<0x7ff>, trunk_fwd<0x7ff>, trunk_fwd<0x7ff>, trunk_fwd<0x7ff>, trunk_fwd<0x7ff>, trunk_fwd<0x7ff>, trunk_fwd<0x7ff>};
#else
    static const kern_t kerns[11] = {trunk_fwd<0x1>, trunk_fwd<0x400>, trunk_fwd<0x4>, trunk_fwd<0x8>, trunk_fwd<0x10>, trunk_fwd<0x20>, trunk_fwd<0x40>, trunk_fwd<0x400>, trunk_fwd<0x100>, trunk_fwd<0x200>, trunk_fwd<0x400>};
#endif
    if (grid == 0) {
        if (n_in != 11 || out_size != MTOK * DM || ws_size < WS_END) { fprintf(stderr, "kernel_launch: unexpected shapes (n_in %d, out %d, ws %zu)\n", n_in, out_size, ws_size); grid = -1; return; }
        int dev = 0, cus = 0;
        if (hipGetDevice(&dev) != hipSuccess || hipDeviceGetAttribute(&cus, hipDeviceAttributeMultiprocessorCount, dev) != hipSuccess) { grid = -1; return; }
        for (int i = 0; i < 11; ++i) {
            if (hipFuncSetAttribute((const void*)kerns[i], hipFuncAttributeMaxDynamicSharedMemorySize, LDS_BYTES) != hipSuccess) { fprintf(stderr, "kernel_launch: hipFuncSetAttribute failed\n"); grid = -1; return; }
            int per_cu = 0;
            if (hipOccupancyMaxActiveBlocksPerMultiprocessor(&per_cu, (const void*)kerns[i], NWAVES * 64, LDS_BYTES) != hipSuccess || per_cu < 1) { fprintf(stderr, "kernel_launch: occupancy query reports %d for site %d\n", per_cu, i); }
        }
        (void)hipGetLastError();
        grid = cus;
    }
    if (grid < 0) return;
    if (hipMemsetAsync((char*)d_ws + WS_CTL, 0, CTL_ZERO_BYTES, stream) != hipSuccess) return;
    Args a{};
    a.in[0] = (const float*)d_in[0]; a.pos = (const int*)d_in[1]; a.in[1] = nullptr;
    for (int i = 2; i < 11; ++i) a.in[i] = (const float*)d_in[i];
    a.out = (float*)d_out; a.ws = (unsigned char*)d_ws;
#if MK_ONE_LAUNCH
    a.ph_lo = 0; a.ph_hi = N_PHASES;
    hipLaunchKernelGGL(kerns[0], dim3(grid), dim3(NWAVES * 64), LDS_BYTES, stream, a);
#else
    for (int p = 0; p < N_PHASES; ++p) { a.ph_lo = p; a.ph_hi = p + 1; hipLaunchKernelGGL(kerns[site_of_phase(p)], dim3(grid), dim3(NWAVES * 64), LDS_BYTES, stream, a); }
#endif
}
```

```cpp
#include <hip/hip_runtime.h>
#include <cstdio>
#include <cstdint>

#ifndef PROBE_DUP
#define PROBE_DUP 0
#endif
#ifndef PROBE_ATT1
#define PROBE_ATT1 0
#endif
#ifndef PG8_ALIGN
#define PG8_ALIGN 1
#endif
#ifndef MK_ONE_LAUNCH
#define MK_ONE_LAUNCH 1
#endif

#define LAS __attribute__((address_space(3)))
#define GAS __attribute__((address_space(1)))
typedef unsigned short bf16_t;
typedef short bf16x8 __attribute__((ext_vector_type(8)));
typedef short s16x4 __attribute__((ext_vector_type(4)));
typedef float f32x4 __attribute__((ext_vector_type(4)));
typedef float f32x2 __attribute__((ext_vector_type(2)));
typedef float f32x16 __attribute__((ext_vector_type(16)));
typedef unsigned u32x4 __attribute__((ext_vector_type(4)));
typedef unsigned u32x2 __attribute__((ext_vector_type(2)));
typedef __bf16 bf16x2_t __attribute__((ext_vector_type(2)));
typedef GAS unsigned gu32;

__device__ __forceinline__ unsigned pk2(float lo, float hi) { f32x2 v = {lo, hi}; bf16x2_t b = __builtin_convertvector(v, bf16x2_t); return __builtin_bit_cast(unsigned, b); }
__device__ __forceinline__ u32x4 pk8(const f32x4& a, const f32x4& b) { u32x4 w; w.x = pk2(a[0], a[1]); w.y = pk2(a[2], a[3]); w.z = pk2(b[0], b[1]); w.w = pk2(b[2], b[3]); return w; }
__device__ __forceinline__ float bf2f(unsigned short h) { return __builtin_bit_cast(float, (unsigned)h << 16); }


__device__ __forceinline__ int otid() { int t = threadIdx.x; asm volatile("" : "+v"(t)); return t; }
__device__ __forceinline__ unsigned char* optr(unsigned char* p) { asm volatile("" : "+s"(p)); return p; }

constexpr int SEQ = 2048, DM = 1024, NBATCH = 16, MTOK = NBATCH * SEQ, MH = MTOK / 2, FF = 4096;
constexpr int NIN = 7424;
constexpr int COLT = 7244;
constexpr float LOG2E = 1.4426950408889634f;
constexpr float C2S = 0.125f * LOG2E;
constexpr float NEGBIG = -1.0e30f;

constexpr size_t MiB = 1u << 20;
constexpr size_t WS_CTL = 0, CTL_ZERO_BYTES = 1 * MiB;
constexpr size_t WS_W = 2 * MiB, W_LAYER = 36 * MiB;
constexpr size_t W_IN = 0, W_BR = 15 * MiB, W_OUT = 18 * MiB, W_UP = 20 * MiB, W_DN = 28 * MiB;
constexpr size_t WS_XB = 74 * MiB;
constexpr size_t WS_RS = 138 * MiB;
constexpr size_t WS_CS = 139 * MiB;
constexpr size_t WS_KI = 141 * MiB;
constexpr size_t WS_WI = 143 * MiB;
constexpr size_t WS_LF = 143 * MiB + 512 * 1024;
constexpr size_t WS_SEL = 144 * MiB;
constexpr size_t WS_QKV = 148 * MiB;
constexpr size_t WS_CB = 244 * MiB;
constexpr size_t WS_G = 276 * MiB;
constexpr size_t WS_Y = 372 * MiB;
constexpr size_t WS_HID = 148 * MiB;
constexpr size_t WS_XL = 436 * MiB;
constexpr size_t WS_END = 500 * MiB;
static_assert(WS_HID + (size_t)MTOK * FF * 2 <= WS_END, "hidden overlay");
constexpr int CW_TMO = 0, CW_BAR = 4096, CW_Q = 8192, CW_FIN = 16384;
constexpr size_t SS_OFF = 262144, SS_STRIDE = 131072;

constexpr int LDS_BYTES = 147456;
constexpr int MISC_OFF = LDS_BYTES - 256;
constexpr int NWAVES = 8;

#define XB_TMO      128
#define XB_XCNT(j)  (256  + 64 * (j))
#define XB_XSUB(j)  (1280 + 64 * (j))
#define XB_XGEN(j)  (2304 + 64 * (j))
#define XB_TOP      3328
#define XB_TOPGEN   3392
#define XCD_BAR_WORDS 3456
#define XB_SPIN_CAP (1u << 18)
__device__ __forceinline__ unsigned xb_ld(unsigned* p)              { return __hip_atomic_load(p, __ATOMIC_RELAXED, __HIP_MEMORY_SCOPE_AGENT); }
__device__ __forceinline__ unsigned xb_add(unsigned* p, unsigned v) { return __hip_atomic_fetch_add(p, v, __ATOMIC_RELAXED, __HIP_MEMORY_SCOPE_AGENT); }
__device__ __forceinline__ unsigned xb_xcc_id() { return (unsigned)__builtin_amdgcn_s_getreg((3 << 11) | 20) & 0xFu; }
#define XB_SPIN(cond, bar) do { unsigned _sp = 0; while (cond) { __builtin_amdgcn_s_sleep(1); \
    if ((++_sp & 255u) == 0u) { if (xb_ld(&(bar)[XB_TMO])) break; if (_sp > XB_SPIN_CAP) { atomicAdd(&(bar)[XB_TMO], 1u); break; } } } } while (0)
struct XcdBarrier { unsigned* bar; unsigned x; volatile LAS unsigned* st; };
__device__ __forceinline__ XcdBarrier xcd_barrier_post(unsigned* bar, volatile LAS unsigned* st) {
    XcdBarrier b; b.bar = bar; b.x = xb_xcc_id(); b.st = st;
    if (threadIdx.x == 0) (void)xb_add(&bar[XB_XCNT(b.x)], 1u);
    return b;
}
__device__ __forceinline__ void xcd_barrier_complete(unsigned* bar, unsigned x, unsigned& nloc, unsigned& nx) {
    const unsigned G = gridDim.x * gridDim.y * gridDim.z;
    unsigned sum, cnt, mine, sp = 0u;
    for (;;) {
        sum = 0u; cnt = 0u; mine = 0u;
#pragma unroll
        for (unsigned j = 0; j < 16; ++j) { const unsigned c = xb_ld(&bar[XB_XCNT(j)]); sum += c; cnt += (c > 0u) ? 1u : 0u; mine = (j == x) ? c : mine; }
        if (sum == G) break;
        __builtin_amdgcn_s_sleep(1);
        if ((++sp & 255u) == 0u) { if (xb_ld(&bar[XB_TMO])) break; if (sp > XB_SPIN_CAP) { atomicAdd(&bar[XB_TMO], 1u); break; } }
    }
    nloc = mine > 0u ? mine : 1u; nx = cnt > 0u ? cnt : 1u;
}
__device__ __forceinline__ void xcd_barrier(const XcdBarrier& b) {
    asm volatile("s_waitcnt vmcnt(0)" ::: "memory");
    __syncthreads();
    if (threadIdx.x == 0) {
        unsigned* bar = b.bar;
        __builtin_amdgcn_s_waitcnt(0);
        unsigned nloc = b.st[0], nx = b.st[1];
        if (nloc == 0u) { xcd_barrier_complete(bar, b.x, nloc, nx); b.st[0] = nloc; b.st[1] = nx; }
        const unsigned old = xb_add(&bar[XB_XSUB(b.x)], 1u);
        const unsigned gen = old / nloc;
        if (old + 1u == (gen + 1u) * nloc) {
            __builtin_amdgcn_fence(__ATOMIC_RELEASE, "agent");
            asm volatile("s_waitcnt vmcnt(0)" ::: "memory");
            const unsigned og = xb_add(&bar[XB_TOP], 1u);
            const unsigned tg = og / nx;
            if (og + 1u == (tg + 1u) * nx) xb_add(&bar[XB_TOPGEN], 1u);
            else XB_SPIN(xb_ld(&bar[XB_TOPGEN]) == tg, bar);
            __builtin_amdgcn_fence(__ATOMIC_ACQUIRE, "agent");
            xb_add(&bar[XB_XGEN(b.x)], 1u);
            asm volatile("s_waitcnt vmcnt(0)" ::: "memory");
        } else {
            XB_SPIN(xb_ld(&bar[XB_XGEN(b.x)]) == gen, bar);
            __builtin_amdgcn_fence(__ATOMIC_ACQUIRE, "agent");
            asm volatile("s_waitcnt vmcnt(0)" ::: "memory");
        }
    }
    __syncthreads();
}

namespace pg8 {
constexpr int BM = 256, BK = 64, HALF = 128, HTB = HALF * BK * 2, STAGE_BYTES = 8 * HTB, NXCD = 8, WGM = 8;
__host__ __device__ __forceinline__ int lds_byte(int r, int c) { const int st = (r >> 4) * 2 + (c >> 5), rr = r & 15, cc = c & 31, ob = rr * 64 + cc * 2; return st * 1024 + (ob ^ (((ob >> 9) & 1) << 5)); }
__host__ __device__ __forceinline__ void stage_rc(int b, int& R, int& C) { const int st = b / 1024, sb = b % 1024, swz = sb ^ (((sb >> 9) & 1) << 5); R = (st >> 1) * 16 + swz / 64; C = (st & 1) * 32 + (swz % 64) / 2; }
__host__ __device__ __forceinline__ int perm32(int rho) { const int n = rho >> 4, i = rho & 15; return 8 * (i >> 2) + 4 * n + (i & 3); }

struct Unit { int pm, pn, sub; const char* A; const char* B; };

template <int nM, int nN, int nsub, int LDA, int LDB, int bsubE, int asub1, int asub2>
struct TileOrder {
    static constexpr int nwg = nM * nN; static constexpr size_t atile = (size_t)256 * LDA * 2, btile = (size_t)256 * LDB * 2, bsub = (size_t)bsubE * 2;
    int G, c;
    const char* A; const char* B;
    __device__ __forceinline__ bool next(int i, Unit& u) const {
        const int ti = i / nsub, sub = i - ti * nsub;
        const long L = (long)ti * G + c; if (L >= nwg) return false;
        int wgid = (int)L; { const int q = nwg / NXCD, r = nwg % NXCD, xcd = wgid % NXCD, off = wgid / NXCD; wgid = (xcd < r ? xcd * (q + 1) : r * (q + 1) + (xcd - r) * q) + off; }
        const int nig = WGM * nN, gid = wgid / nig, fm = gid * WGM, gsz = (nM - fm) < WGM ? (nM - fm) : WGM;
        u.pm = fm + ((wgid % nig) % gsz); u.pn = (wgid % nig) / gsz; u.sub = sub;
        u.A = A + (size_t)u.pm * atile + (sub == 0 ? 0 : (sub == 1 ? asub1 : asub2));
        u.B = B + (size_t)u.pn * btile + (size_t)sub * bsub;
        return true;
    }
};

template <int K, int lda, int ldb, class Epi, class Sched>
__device__ __forceinline__ void gemm_phase(LAS unsigned char* lds, const Sched& S, const Epi& E) {
    const int tid = otid(), wid = __builtin_amdgcn_readfirstlane(tid >> 6), lane = tid & 63, wr = wid >> 2, wc = wid & 3, fr = lane & 15, fq = lane >> 4;
    constexpr int nt = K / BK;
    unsigned voffA[2], voffB[2];
#pragma unroll
    for (int i = 0; i < 2; ++i) { int R, C; stage_rc(tid * 16 + i * 8192, R, C); const int Rb = (R & ~31) + perm32(R & 31);
        voffA[i] = (unsigned)(R * lda + C) * 2u; voffB[i] = (unsigned)(Rb * ldb + C) * 2u; }
    const size_t kstep = (size_t)(BK * 2);
    const size_t hstepA = (size_t)HALF * lda * 2, hstepB = (size_t)HALF * ldb * 2;
    const unsigned ldsw = (unsigned)wid * 1024u;
    const int aoff = lds_byte(wr * 64 + fr, fq * 8), boff = lds_byte(wc * 32 + fr, fq * 8);
#define PG8_SA(b, h) (((b) * 2 + (h)) * HTB)
#define PG8_SB(b, h) ((4 + (b) * 2 + (h)) * HTB)
#define PG8_STAGE(bufoff, gbase, voff) do { _Pragma("unroll") for (int _i = 0; _i < 2; ++_i) \
        __builtin_amdgcn_global_load_lds((const unsigned*)((const char*)(gbase) + (voff)[_i]), (LAS unsigned*)(lds + (bufoff) + ldsw + _i * 8192), 16, 0, 0); } while (0)
#define PG8_LDA(dst, b, h) do { _Pragma("unroll") for (int m = 0; m < 4; ++m) _Pragma("unroll") for (int k = 0; k < 2; ++k) dst[m][k] = *(const LAS bf16x8*)(lds + PG8_SA(b, h) + aoff + m * 2048 + k * 1024); } while (0)
#define PG8_LDB(dst, b, h) do { _Pragma("unroll") for (int n = 0; n < 2; ++n) _Pragma("unroll") for (int k = 0; k < 2; ++k) dst[n][k] = *(const LAS bf16x8*)(lds + PG8_SB(b, h) + boff + n * 2048 + k * 1024); } while (0)
#define PG8_MMA(ai, bj, At, Bt) do { __builtin_amdgcn_s_setprio(1); _Pragma("unroll") for (int m = 0; m < 4; ++m) _Pragma("unroll") for (int n = 0; n < 2; ++n) _Pragma("unroll") for (int k = 0; k < 2; ++k) \
        acc[ai][bj][m][n] = __builtin_amdgcn_mfma_f32_16x16x32_bf16(Bt[n][k], At[m][k], acc[ai][bj][m][n], 0, 0, 0); __builtin_amdgcn_s_setprio(0); } while (0)
#define PG8_WAIT_V(n) asm volatile("s_waitcnt vmcnt(" #n ")" ::: "memory")
#define PG8_WAIT_L(n) asm volatile("s_waitcnt lgkmcnt(" #n ")" ::: "memory")
#define PG8_BAR __builtin_amdgcn_s_barrier()
#define PG8_SCHED __builtin_amdgcn_sched_barrier(0)
    Unit cur, nxt; int ui = 0;
    if (!S.next(0, cur)) return;
    f32x4 acc[2][2][4][2];
#pragma unroll
    for (int a = 0; a < 2; ++a)
#pragma unroll
        for (int b = 0; b < 2; ++b)
#pragma unroll
            for (int m = 0; m < 4; ++m)
#pragma unroll
                for (int n = 0; n < 2; ++n) acc[a][b][m][n] = (f32x4){0.f, 0.f, 0.f, 0.f};
    bf16x8 At[4][2], B0[2][2], B1[2][2];
    const char* cA = cur.A; const char* cB = cur.B;
    PG8_STAGE(PG8_SB(0, 0), cB, voffB); PG8_STAGE(PG8_SB(0, 1), cB + hstepB, voffB); PG8_STAGE(PG8_SA(0, 0), cA, voffA); PG8_STAGE(PG8_SA(0, 1), cA + hstepA, voffA);
    if (wr == 1) PG8_BAR;
    PG8_WAIT_V(2); PG8_BAR;
    PG8_STAGE(PG8_SB(1, 0), cB + kstep, voffB); PG8_STAGE(PG8_SA(1, 0), cA + kstep, voffA); PG8_STAGE(PG8_SB(1, 1), cB + hstepB + kstep, voffB);
    PG8_WAIT_V(6); PG8_BAR;
    for (;;) {
        const bool has_next = S.next(ui + 1, nxt);
        const char* nA = has_next ? nxt.A : cA; const char* nB = has_next ? nxt.B : cB;
        for (int t = 0; t < nt; t += 2) {
            const bool last = (t == nt - 2);
            const char* a1 = cA + (size_t)(t + 1) * kstep;
            const char* a2 = last ? nA : cA + (size_t)(t + 2) * kstep; const char* b2 = last ? nB : cB + (size_t)(t + 2) * kstep;
            const char* a3 = a2 + kstep; const char* b3 = b2 + kstep;
            PG8_LDB(B0, 0, 0); PG8_LDB(B1, 0, 1); PG8_SCHED; PG8_LDA(At, 0, 0); PG8_STAGE(PG8_SA(1, 1), a1 + hstepA, voffA);
            PG8_WAIT_V(8); PG8_WAIT_L(0); PG8_BAR; PG8_MMA(0, 0, At, B0); PG8_MMA(0, 1, At, B1); PG8_BAR; PG8_SCHED;
            PG8_LDA(At, 0, 1); PG8_STAGE(PG8_SB(0, 0), b2, voffB); PG8_STAGE(PG8_SB(0, 1), b2 + hstepB, voffB); PG8_STAGE(PG8_SA(0, 0), a2, voffA);
            PG8_WAIT_V(8); PG8_WAIT_L(0); PG8_BAR; PG8_MMA(1, 0, At, B0); PG8_MMA(1, 1, At, B1); PG8_BAR; PG8_SCHED;
            PG8_LDB(B0, 1, 0); PG8_LDB(B1, 1, 1); PG8_SCHED; PG8_LDA(At, 1, 0); PG8_STAGE(PG8_SA(0, 1), a2 + hstepA, voffA);
            PG8_WAIT_V(8); PG8_WAIT_L(0); PG8_BAR; PG8_MMA(0, 0, At, B0); PG8_MMA(0, 1, At, B1); PG8_BAR; PG8_SCHED;
            PG8_LDA(At, 1, 1); PG8_STAGE(PG8_SB(1, 0), b3, voffB); PG8_STAGE(PG8_SB(1, 1), b3 + hstepB, voffB); PG8_STAGE(PG8_SA(1, 0), a3, voffA);
            PG8_WAIT_V(8); PG8_WAIT_L(0); PG8_BAR; PG8_MMA(1, 0, At, B0); PG8_MMA(1, 1, At, B1); PG8_BAR; PG8_SCHED;
        }
        if (PG8_ALIGN) { if (wr == 0) PG8_BAR; }
        E(acc, cur, wr, wc, fr, fq);
        if (!has_next) break;
        if (nxt.sub == 0) {
#pragma unroll
            for (int a = 0; a < 2; ++a)
#pragma unroll
                for (int b = 0; b < 2; ++b)
#pragma unroll
                    for (int m = 0; m < 4; ++m)
#pragma unroll
                        for (int n = 0; n < 2; ++n) acc[a][b][m][n] = (f32x4){0.f, 0.f, 0.f, 0.f};
        }
        cur = nxt; cA = nA; cB = nB; ++ui;
        if (PG8_ALIGN) { if (wr == 1) PG8_BAR; }
    }
    PG8_WAIT_V(0);
    if (!PG8_ALIGN) { if (wr == 0) PG8_BAR; }
    PG8_BAR;
#undef PG8_SA
#undef PG8_SB
#undef PG8_STAGE
#undef PG8_LDA
#undef PG8_LDB
#undef PG8_MMA
#undef PG8_WAIT_V
#undef PG8_WAIT_L
#undef PG8_BAR
#undef PG8_SCHED
}

__device__ __forceinline__ float sigmoidf_(float v) { return __builtin_amdgcn_rcpf(1.0f + __builtin_amdgcn_exp2f(-LOG2E * v)); }
__device__ __forceinline__ float rs_of(float ss) { return __builtin_amdgcn_rsqf(ss * (1.0f / DM) + 1e-6f); }
__device__ __forceinline__ float logsigmoidf_(float x) { return fminf(x, 0.f) - log1pf(__expf(-fabsf(x))); }

struct EpiInProj {
    GAS bf16_t* QKV; GAS bf16_t* CB; GAS unsigned char* G; GAS bf16_t* KI; GAS float* WI; GAS float* LF; const GAS float* SS; const GAS float* CS; const GAS float* bfg; int tok0;
    __device__ __forceinline__ void operator()(f32x4 (&acc)[2][2][4][2], const Unit& u, int wr, int wc, int fr, int fq) const {
        const int pn = u.pn; const int rbase = u.pm * BM + wr * 64 + fr; const int cw = wc * 32 + 8 * fq;
        if (pn < 12) {
            const float sc = (pn < 2 || pn == 6 || pn == 7) ? C2S : 1.0f;
#pragma unroll
            for (int ai = 0; ai < 2; ++ai)
#pragma unroll
                for (int m = 0; m < 4; ++m) { const int row = rbase + ai * HALF + m * 16; const float rs = rs_of(SS[tok0 + row]) * sc; GAS bf16_t* rowp = QKV + (size_t)row * 3072 + pn * 256 + cw;
#pragma unroll
                    for (int bj = 0; bj < 2; ++bj) *(GAS u32x4*)(rowp + bj * HALF) = pk8(acc[ai][bj][m][0] * rs, acc[ai][bj][m][1] * rs); }
        } else if (pn < 16) {
            const bool ropew = ((wc & 1) == 0);
#pragma unroll
            for (int ai = 0; ai < 2; ++ai)
#pragma unroll
                for (int m = 0; m < 4; ++m) { const int row = rbase + ai * HALF + m * 16; const float rs = rs_of(SS[tok0 + row]);
                    f32x4 c0 = {0, 0, 0, 0}, c1 = c0, s0 = c0, s1 = c0;
                    if (ropew) { const GAS f32x4* cp = (const GAS f32x4*)(CS + (size_t)(tok0 + row) * 16); c0 = cp[0]; c1 = cp[1]; s0 = cp[2]; s1 = cp[3]; }
#pragma unroll
                    for (int bj = 0; bj < 2; ++bj) { const int cl = (pn - 12) * 256 + bj * HALF + cw;
                        f32x4 v0 = acc[ai][bj][m][0] * rs, v1 = acc[ai][bj][m][1] * rs;
                        if (ropew && !(pn == 14 && bj == 1)) {
                            const float sg = (fq == 0) ? -1.f : 1.f;
#pragma unroll
                            for (int e = 0; e < 4; ++e) { const float p0 = __shfl_xor(v0[e], 16), p1 = __shfl_xor(v1[e], 16);
                                const float r0 = v0[e] * c0[e] + sg * p0 * s0[e], r1 = v1[e] * c1[e] + sg * p1 * s1[e];
                                if (fq < 2) { v0[e] = r0; v1[e] = r1; } }
                        }
                        const float sc = (cl < 512) ? C2S : ((cl >= 768) ? 0.125f : 1.0f);
                        *(GAS u32x4*)(CB + (size_t)row * 1024 + cl) = pk8(v0 * sc, v1 * sc); } }
        } else {
#pragma unroll
            for (int ai = 0; ai < 2; ++ai)
#pragma unroll
                for (int m = 0; m < 4; ++m) { const int row = rbase + ai * HALF + m * 16; const float rs = rs_of(SS[tok0 + row]);
                    GAS unsigned char* gp = G + ((size_t)(u.pm * 12 + (pn - 16)) << 16) + (size_t)((wr * 4 + wc) * 8192 + (ai * 4 + m) * 1024 + (fq * 16 + fr) * 16);
                    u32x4 gw;
#pragma unroll
                    for (int bj = 0; bj < 2; ++bj) { f32x4 v0 = acc[ai][bj][m][0] * rs, v1 = acc[ai][bj][m][1] * rs;
                        unsigned w0 = 0u, w1 = 0u;
#pragma unroll
                        for (int e = 0; e < 4; ++e) { w0 = __builtin_amdgcn_cvt_pk_u8_f32(__builtin_rintf(sigmoidf_(v0[e]) * 255.0f), e, w0); w1 = __builtin_amdgcn_cvt_pk_u8_f32(__builtin_rintf(sigmoidf_(v1[e]) * 255.0f), e, w1); }
                        gw[2 * bj] = w0; gw[2 * bj + 1] = w1; }
                    *(GAS u32x4*)gp = gw; }
        }
    }
};

struct EpiBranch {
    const GAS unsigned char* G; GAS bf16_t* Y; int tok0;
    __device__ __forceinline__ void operator()(f32x4 (&acc)[2][2][4][2], const Unit& u, int wr, int wc, int fr, int fq) const {
        const int rbase = u.pm * BM + wr * 64 + fr; const int cw = u.pn * 256 + wc * 32 + 8 * fq; const int sub = u.sub;
#pragma unroll
        for (int ai = 0; ai < 2; ++ai)
#pragma unroll
            for (int m = 0; m < 4; ++m) { const int row = rbase + ai * HALF + m * 16;
                const GAS unsigned char* gp = G + ((size_t)(u.pm * 12 + sub * 4 + u.pn) << 16) + (size_t)((wr * 4 + wc) * 8192 + (ai * 4 + m) * 1024 + (fq * 16 + fr) * 16);
                const u32x4 ga4 = *(const GAS u32x4*)gp;
                u32x4 gb4 = ga4;
                if (sub < 2) gb4 = *(const GAS u32x4*)(gp + 262144);
#pragma unroll
                for (int bj = 0; bj < 2; ++bj) {
                    const u32x2 ga = {ga4[2 * bj], ga4[2 * bj + 1]};
                    float f[8];
                    if (sub < 2) { const u32x2 gb = {gb4[2 * bj], gb4[2 * bj + 1]};
#pragma unroll
                        for (int e = 0; e < 8; ++e) { const float a = (float)((ga[e >> 2] >> (8 * (e & 3))) & 0xffu), b = fmaxf((float)((gb[e >> 2] >> (8 * (e & 3))) & 0xffu), 0.25f);
                            f[e] = ((sub == 0) ? a : fmaxf(a, 0.25f)) * __builtin_amdgcn_rcpf(b); }
                    } else {
#pragma unroll
                        for (int e = 0; e < 8; ++e) f[e] = fmaxf((float)((ga[e >> 2] >> (8 * (e & 3))) & 0xffu), 0.25f) * (1.0f / 255.0f);
                    }
                    f32x4 v0 = acc[ai][bj][m][0], v1 = acc[ai][bj][m][1];
                    v0[0] *= f[0]; v0[1] *= f[1]; v0[2] *= f[2]; v0[3] *= f[3]; v1[0] *= f[4]; v1[1] *= f[5]; v1[2] *= f[6]; v1[3] *= f[7];
                    if (sub < 2) { acc[ai][bj][m][0] = v0; acc[ai][bj][m][1] = v1; }
                    else *(GAS u32x4*)(Y + (size_t)(tok0 + row) * 1024 + cw + bj * HALF) = pk8(v0, v1);
                } }
    }
};

struct EpiResid {
    GAS bf16_t* XB; GAS bf16_t* XL; GAS float* SS;
    GAS float* OUT; const GAS float* GF; GAS unsigned* CNT; int fin; const GAS float* X32;
    __device__ __forceinline__ void operator()(f32x4 (&acc)[2][2][4][2], const Unit& u, int wr, int wc, int fr, int fq) const {
        const int rbase = u.pm * BM + wr * 64 + fr; const int cw = u.pn * 256 + wc * 32 + 8 * fq;
        if (fin) { final_norm(acc, u, rbase, cw, fq); return; }
#pragma unroll
        for (int ai = 0; ai < 2; ++ai)
#pragma unroll
            for (int m = 0; m < 4; ++m) { const int row = rbase + ai * HALF + m * 16; const size_t off = (size_t)row * 1024 + cw; float ss = 0.f;
#pragma unroll
                for (int bj = 0; bj < 2; ++bj) {
                    float x[8];
                    if (X32) { const f32x4 a = *(const GAS f32x4*)(X32 + off + bj * HALF), b = *(const GAS f32x4*)(X32 + off + bj * HALF + 4);
#pragma unroll
                        for (int e = 0; e < 4; ++e) { x[e] = a[e]; x[4 + e] = b[e]; }
                    } else { const u32x4 h = *(const GAS u32x4*)(XB + off + bj * HALF), l = *(const GAS u32x4*)(XL + off + bj * HALF);
#pragma unroll
                        for (int e = 0; e < 4; ++e) { x[2 * e] = __uint_as_float(h[e] << 16) + __uint_as_float(l[e] << 16); x[2 * e + 1] = __uint_as_float(h[e] & 0xffff0000u) + __uint_as_float(l[e] & 0xffff0000u); }
                    }
#pragma unroll
                    for (int e = 0; e < 4; ++e) { x[e] += acc[ai][bj][m][0][e]; x[4 + e] += acc[ai][bj][m][1][e]; }
                    u32x4 hn, ln;
#pragma unroll
                    for (int e = 0; e < 4; ++e) { hn[e] = pk2(x[2 * e], x[2 * e + 1]);
                        ln[e] = pk2(x[2 * e] - __uint_as_float(hn[e] << 16), x[2 * e + 1] - __uint_as_float(hn[e] & 0xffff0000u)); }
                    *(GAS u32x4*)(XB + off + bj * HALF) = hn; *(GAS u32x4*)(XL + off + bj * HALF) = ln;
#pragma unroll
                    for (int e = 0; e < 8; ++e) ss += x[e] * x[e]; }
                ss += __shfl_xor(ss, 16); ss += __shfl_xor(ss, 32);
                if (fq == 0) __hip_atomic_fetch_add(SS + row, ss, __ATOMIC_RELAXED, __HIP_MEMORY_SCOPE_AGENT); }
    }
    __device__ __forceinline__ void final_norm(f32x4 (&acc)[2][2][4][2], const Unit& u, int rbase, int cw, int fq) const {
#pragma unroll
        for (int ai = 0; ai < 2; ++ai)
#pragma unroll
            for (int m = 0; m < 4; ++m) { const int row = rbase + ai * HALF + m * 16; const size_t off = (size_t)row * 1024 + cw; float ss = 0.f;
#pragma unroll
                for (int bj = 0; bj < 2; ++bj) { const u32x4 h = *(const GAS u32x4*)(XB + off + bj * HALF), l = *(const GAS u32x4*)(XL + off + bj * HALF);
                    float x[8];
#pragma unroll
                    for (int e = 0; e < 4; ++e) { x[2 * e] = __uint_as_float(h[e] << 16) + __uint_as_float(l[e] << 16); x[2 * e + 1] = __uint_as_float(h[e] & 0xffff0000u) + __uint_as_float(l[e] & 0xffff0000u); }
#pragma unroll
                    for (int e = 0; e < 4; ++e) { x[e] += acc[ai][bj][m][0][e]; x[4 + e] += acc[ai][bj][m][1][e]; }
                    acc[ai][bj][m][0] = (f32x4){x[0], x[1], x[2], x[3]}; acc[ai][bj][m][1] = (f32x4){x[4], x[5], x[6], x[7]};
#pragma unroll
                    for (int e = 0; e < 8; ++e) ss += x[e] * x[e]; }
                ss += __shfl_xor(ss, 16); ss += __shfl_xor(ss, 32);
                if (fq == 0) __hip_atomic_fetch_add(SS + row, ss, __ATOMIC_RELAXED, __HIP_MEMORY_SCOPE_AGENT); }
        asm volatile("s_waitcnt vmcnt(0)" ::: "memory");
        __builtin_amdgcn_s_barrier();
        if (threadIdx.x == 0) {
            GAS unsigned* c = CNT + u.pm * 64;
            __builtin_amdgcn_fence(__ATOMIC_RELEASE, "agent");
            __hip_atomic_fetch_add(c, 1u, __ATOMIC_RELAXED, __HIP_MEMORY_SCOPE_AGENT);
            int spins = 0;
            while (__hip_atomic_load(c, __ATOMIC_RELAXED, __HIP_MEMORY_SCOPE_AGENT) < 4u && ++spins < (1 << 22)) __builtin_amdgcn_s_sleep(1);
            __builtin_amdgcn_fence(__ATOMIC_ACQUIRE, "agent");
        }
        asm volatile("s_waitcnt vmcnt(0)" ::: "memory");
        __builtin_amdgcn_s_barrier();
        f32x4 g[2][2];
#pragma unroll
        for (int bj = 0; bj < 2; ++bj) { g[bj][0] = *(const GAS f32x4*)(GF + cw + bj * HALF); g[bj][1] = *(const GAS f32x4*)(GF + cw + bj * HALF + 4); }
#pragma unroll
        for (int ai = 0; ai < 2; ++ai)
#pragma unroll
            for (int m = 0; m < 4; ++m) { const int row = rbase + ai * HALF + m * 16; const float rs = rs_of(__hip_atomic_load(SS + row, __ATOMIC_RELAXED, __HIP_MEMORY_SCOPE_AGENT));
                GAS float* op = OUT + (size_t)row * 1024 + cw;
#pragma unroll
                for (int bj = 0; bj < 2; ++bj) { *(GAS f32x4*)(op + bj * HALF) = acc[ai][bj][m][0] * rs * g[bj][0]; *(GAS f32x4*)(op + bj * HALF + 4) = acc[ai][bj][m][1] * rs * g[bj][1]; } }
    }
};

struct EpiUp {
    GAS bf16_t* H; const GAS float* SS;
    __device__ __forceinline__ void operator()(f32x4 (&acc)[2][2][4][2], const Unit& u, int wr, int wc, int fr, int fq) const {
        const int rbase = u.pm * BM + wr * 64 + fr; const int cw = u.pn * 256 + wc * 32 + 8 * fq;
#pragma unroll
        for (int ai = 0; ai < 2; ++ai)
#pragma unroll
            for (int m = 0; m < 4; ++m) { const int row = rbase + ai * HALF + m * 16; const float rs = rs_of(SS[row]); GAS bf16_t* rowp = H + (size_t)row * FF + cw;
#pragma unroll
                for (int bj = 0; bj < 2; ++bj) { f32x4 v0 = acc[ai][bj][m][0] * rs, v1 = acc[ai][bj][m][1] * rs;
#pragma unroll
                    for (int e = 0; e < 4; ++e) { const float a = fmaxf(v0[e], 0.f), b = fmaxf(v1[e], 0.f); v0[e] = a * a; v1[e] = b * b; }
                    *(GAS u32x4*)(rowp + bj * HALF) = pk8(v0, v1); } }
    }
};
}

namespace att {
__device__ __forceinline__ int crow(int r, int hi) { return (r & 3) + 8 * (r >> 2) + 4 * hi; }
typedef short v4i16_t __attribute__((ext_vector_type(4)));
__device__ __forceinline__ s16x4 vtr(const LAS unsigned char* p) { return __builtin_bit_cast(s16x4, __builtin_amdgcn_ds_read_tr16_b64_v4i16((LAS v4i16_t*)p)); }
__device__ __forceinline__ bf16x8 mk8(const s16x4& lo, const s16x4& hi) { return (bf16x8){lo[0], lo[1], lo[2], lo[3], hi[0], hi[1], hi[2], hi[3]}; }
#define CFENCE() asm volatile("" ::: "memory")
__device__ __forceinline__ void xswap(float v, float& a_, float& b_) {
    unsigned a = __builtin_bit_cast(unsigned, v), b = a;
    asm volatile("s_nop 1\n\tv_permlane32_swap_b32 %0, %1\n\ts_nop 1" : "+v"(a), "+v"(b));
    a_ = __builtin_bit_cast(float, a); b_ = __builtin_bit_cast(float, b);
}
__device__ __forceinline__ float xmax(float v) { float a, b; xswap(v, a, b); return fmaxf(a, b); }
__device__ __forceinline__ float xsum(float v) { float a, b; xswap(v, a, b); return a + b; }

__device__ __forceinline__ void pv_tile(f32x16 (&ot)[2], const f32x16& p0, const f32x16& p1, const LAS unsigned char* vimg, int lane) {
    const int hi = lane >> 5;
    const LAS unsigned char* vb = vimg + ((lane >> 4) & 1) * 32 + (lane & 3) * 8 + (4 * hi + ((lane & 15) >> 2)) * 64;
    bf16x8 pf[4];
    { u32x4 w;
      w.x = pk2(p0[0], p0[1]); w.y = pk2(p0[2], p0[3]); w.z = pk2(p0[4], p0[5]); w.w = pk2(p0[6], p0[7]); pf[0] = __builtin_bit_cast(bf16x8, w);
      w.x = pk2(p0[8], p0[9]); w.y = pk2(p0[10], p0[11]); w.z = pk2(p0[12], p0[13]); w.w = pk2(p0[14], p0[15]); pf[1] = __builtin_bit_cast(bf16x8, w);
      w.x = pk2(p1[0], p1[1]); w.y = pk2(p1[2], p1[3]); w.z = pk2(p1[4], p1[5]); w.w = pk2(p1[6], p1[7]); pf[2] = __builtin_bit_cast(bf16x8, w);
      w.x = pk2(p1[8], p1[9]); w.y = pk2(p1[10], p1[11]); w.z = pk2(p1[12], p1[13]); w.w = pk2(p1[14], p1[15]); pf[3] = __builtin_bit_cast(bf16x8, w); }
#pragma unroll
    for (int db = 0; db < 2; ++db)
#pragma unroll
        for (int ks = 0; ks < 4; ++ks) {
            const s16x4 lo = vtr(vb + db * 4096 + ks * 1024), hh = vtr(vb + db * 4096 + ks * 1024 + 512);
            ot[db] = __builtin_amdgcn_mfma_f32_32x32x16_bf16(mk8(lo, hh), pf[ks], ot[db], 0, 0, 0);
        }
}
__device__ __forceinline__ void store_ot(const f32x16 (&ot)[2], float scale, GAS bf16_t* obase  , int ldo, LAS unsigned char* stage, int lane) {
    const int ql = lane & 31, hi = lane >> 5;
#pragma unroll
    for (int db = 0; db < 2; ++db)
#pragma unroll
        for (int g = 0; g < 4; ++g) { u32x2 w; w.x = pk2(ot[db][4 * g] * scale, ot[db][4 * g + 1] * scale); w.y = pk2(ot[db][4 * g + 2] * scale, ot[db][4 * g + 3] * scale);
            *(LAS u32x2*)(stage + ql * 144 + (db * 32 + 8 * g + 4 * hi) * 2) = w; }
    CFENCE();
#pragma unroll
    for (int i = 0; i < 4; ++i) { const int id = i * 64 + lane, row = id >> 3, ch = id & 7;
        const u32x4 v = *(const LAS u32x4*)(stage + row * 144 + ch * 16);
        *(GAS u32x4*)(obase + (size_t)row * ldo + ch * 8) = v; }
    CFENCE();
}

template <int MODE, int ldq, int ldkv, int ldo>
__device__ __forceinline__ void flash_unit(LAS unsigned char* lds, const GAS bf16_t* Qp, const GAS bf16_t* Kp, const GAS bf16_t* Vp, GAS bf16_t* Op,
                                           int qb, const GAS float* lf, const GAS unsigned* seli) {
    constexpr float THR = 8.0f;
    const int tid = otid(), lane = tid & 63, wid = __builtin_amdgcn_readfirstlane(tid >> 6), ql = lane & 31, hi = lane >> 5;
    const int blk = (wid < 4) ? wid : 11 - wid;
    const int q0 = qb * 256, qs = q0 + blk * 32, NT = 4 * (qb + 1);
    LAS float* cbias = (LAS float*)(lds + 32768);
    LAS unsigned* cbw = (LAS unsigned*)(lds + 32768);
    LAS float* scanw = (LAS float*)(lds + 41472);
    bf16x8 qf[4];
    { const GAS bf16_t* qp = Qp + (size_t)(qs + ql) * ldq + 8 * hi;
#pragma unroll
      for (int ks = 0; ks < 4; ++ks) qf[ks] = *(const GAS bf16x8*)(qp + 16 * ks); }
    const int kkey = tid >> 3, kc = tid & 7;
    const unsigned kst = (unsigned)(kkey * 128 + ((kc ^ ((kkey >> 1) & 7)) << 4));
    const int vkey = (tid >> 2) & 63, vc = (tid & 3) + 4 * (tid >> 8);
    const unsigned vst = (unsigned)((vc >> 2) * 4096 + vkey * 64 + (vc & 3) * 16);
    const GAS bf16_t* kg = Kp + (size_t)kkey * ldkv + kc * 8;
    const GAS bf16_t* vg = Vp + (size_t)vkey * ldkv + vc * 8;
    constexpr size_t tstep = (size_t)64 * ldkv;
    const GAS unsigned* selp = (MODE == 1) ? (seli + (size_t)(qs + ql) * 64) : nullptr;
    u32x4 krA, vrA, krB, vrB, k0s_, v0s_; u32x2 w2 = {0u, 0u}, wA = {0u, 0u}, wB = {0u, 0u};
    { const u32x4 k0_ = *(const GAS u32x4*)kg, v0_ = *(const GAS u32x4*)vg; if (MODE == 1) w2 = *(const GAS u32x2*)selp;
      krA = *(const GAS u32x4*)(kg + tstep); vrA = *(const GAS u32x4*)(vg + tstep); if (MODE == 1) wA = *(const GAS u32x2*)(selp + 2);
      krB = krA; vrB = vrA; wB = wA;
      if (NT > 2) { krB = *(const GAS u32x4*)(kg + 2 * tstep); vrB = *(const GAS u32x4*)(vg + 2 * tstep); if (MODE == 1) wB = *(const GAS u32x2*)(selp + 4); }
      k0s_ = k0_; v0s_ = v0_; }
    if (MODE == 0) {
        const int nq = q0 + 256; const int t4 = 4 * tid;
        f32x4 v = {0.f, 0.f, 0.f, 0.f}; if (t4 < nq) v = *(const GAS f32x4*)(lf + t4);
        const float a0 = v[0], a1 = a0 + v[1], a2 = a1 + v[2], a3 = a2 + v[3];
        float s = a3;
#pragma unroll
        for (int o = 1; o < 64; o <<= 1) { const float t = __shfl_up(s, o); if (lane >= o) s += t; }
        if (lane == 63) scanw[wid] = s;
        __syncthreads();
        float woff = 0.f;
#pragma unroll
        for (int w = 0; w < 8; ++w) { const float x = scanw[w]; if (w < wid) woff += x; }
        const float ex = woff + (s - a3);
        if (t4 < nq) *(LAS f32x4*)(cbias + t4) = (f32x4){ex + a0, ex + a1, ex + a2, ex + a3};
        __syncthreads();
        const float cref = cbias[q0];
        __syncthreads();
        if (t4 < nq) { const f32x4 c = *(LAS f32x4*)(cbias + t4); u32x4 w;
#pragma unroll
            for (int e = 0; e < 4; ++e) { const float b = cref - c[e]; const unsigned hb = pk2(b, 0.f) & 0xffffu; const float lo = b - __builtin_bit_cast(float, hb << 16); w[e] = hb | (pk2(lo, 0.f) << 16); }
            *(LAS u32x4*)(cbw + t4) = w; }
        if (tid < 64) cbw[2048 + tid] = 0u;
    }
    *(LAS u32x4*)(lds + kst) = k0s_; *(LAS u32x4*)(lds + 16384 + vst) = v0s_;
    __syncthreads();
    const unsigned kfb = (unsigned)(ql * 128); const int swz = (ql >> 1) & 7;
    const int bidx = hi ? 2048 : ql;
    const bf16x8 ones = __builtin_bit_cast(bf16x8, (u32x4){0x3f803f80u, 0u, 0u, 0u});
    float mhat = 0.f, lsum = 0.f; f32x16 ot[2]; ot[0] = (f32x16){}; ot[1] = (f32x16){};
    f32x16 negm = (f32x16){};
    const unsigned NEGB = __builtin_bit_cast(unsigned, NEGBIG);
#define FLASH_TILE(j, cur) do { \
        if (64 * (j) <= qs + 31) { \
            f32x16 p0, p1; \
            const LAS unsigned char* kb = lds + (cur) * 8192 + kfb; \
            bf16x8 k0[4], k1[4]; \
            _Pragma("unroll") for (int ks = 0; ks < 4; ++ks) { k0[ks] = *(const LAS bf16x8*)(kb + (((2 * ks + hi) ^ swz) << 4)); k1[ks] = *(const LAS bf16x8*)(kb + 4096 + (((2 * ks + hi) ^ swz) << 4)); } \
            if (MODE == 0) { \
                const unsigned b0 = cbw[(hi ? 0 : 64 * (j)) + bidx], b1 = cbw[(hi ? 0 : 64 * (j) + 32) + bidx]; \
                p0 = __builtin_amdgcn_mfma_f32_32x32x16_bf16(__builtin_bit_cast(bf16x8, (u32x4){b0, 0u, 0u, 0u}), ones, negm, 0, 0, 0); \
                p1 = __builtin_amdgcn_mfma_f32_32x32x16_bf16(__builtin_bit_cast(bf16x8, (u32x4){b1, 0u, 0u, 0u}), ones, negm, 0, 0, 0); \
                _Pragma("unroll") for (int ks = 0; ks < 4; ++ks) { p0 = __builtin_amdgcn_mfma_f32_32x32x16_bf16(k0[ks], qf[ks], p0, 0, 0, 0); p1 = __builtin_amdgcn_mfma_f32_32x32x16_bf16(k1[ks], qf[ks], p1, 0, 0, 0); } \
            } else { \
                p0 = __builtin_amdgcn_mfma_f32_32x32x16_bf16(k0[0], qf[0], negm, 0, 0, 0); p1 = __builtin_amdgcn_mfma_f32_32x32x16_bf16(k1[0], qf[0], negm, 0, 0, 0); \
                _Pragma("unroll") for (int ks = 1; ks < 4; ++ks) { p0 = __builtin_amdgcn_mfma_f32_32x32x16_bf16(k0[ks], qf[ks], p0, 0, 0, 0); p1 = __builtin_amdgcn_mfma_f32_32x32x16_bf16(k1[ks], qf[ks], p1, 0, 0, 0); } \
                const unsigned w0 = w2.x >> (4 * hi), w1 = w2.y >> (4 * hi); \
                _Pragma("unroll") for (int r = 0; r < 16; ++r) { const int bp = 8 * (r >> 2) + (r & 3); \
                    const unsigned t0 = (unsigned)(((int)(w0 << (31 - bp))) >> 31), t1 = (unsigned)(((int)(w1 << (31 - bp))) >> 31); \
                    const float s0 = p0[r], s1 = p1[r]; \
                    p0[r] = __uint_as_float((t0 & NEGB) | (~t0 & __float_as_uint(s0))); \
                    p1[r] = __uint_as_float((t1 & NEGB) | (~t1 & __float_as_uint(s1))); } \
            } \
            if (MODE == 0 && 64 * (j) + 63 > qs) { \
                const int qq = qs + ql; \
                _Pragma("unroll") for (int r = 0; r < 16; ++r) { const int key = 64 * (j) + crow(r, hi); if (key > qq) p0[r] = NEGBIG; if (key + 32 > qq) p1[r] = NEGBIG; } \
            } \
            float mx = fmaxf(fmaxf(p0[0], p1[0]), p0[1]); \
            _Pragma("unroll") for (int r = 2; r < 16; r += 2) mx = fmaxf(fmaxf(mx, p0[r]), p0[r + 1]); \
            _Pragma("unroll") for (int r = 1; r < 15; r += 2) mx = fmaxf(fmaxf(mx, p1[r]), p1[r + 1]); \
            mx = fmaxf(mx, p1[15]); \
            mx = xmax(mx); \
            if (__builtin_expect(__any(mx > THR), 0)) { \
                const float dl = fmaxf(mx, 0.f); mhat += dl; \
                _Pragma("unroll") for (int r = 0; r < 16; ++r) { p0[r] -= dl; p1[r] -= dl; negm[r] = -mhat; } \
                const float f = __builtin_amdgcn_exp2f(-dl); lsum *= f; \
                _Pragma("unroll") for (int r = 0; r < 16; ++r) { ot[0][r] *= f; ot[1][r] *= f; } \
            } \
            float ps0 = 0.f, ps1 = 0.f; \
            _Pragma("unroll") for (int r = 0; r < 16; ++r) { p0[r] = __builtin_amdgcn_exp2f(p0[r]); p1[r] = __builtin_amdgcn_exp2f(p1[r]); ps0 += p0[r]; ps1 += p1[r]; } \
            lsum += ps0 + ps1; \
            pv_tile(ot, p0, p1, lds + 16384 + (cur) * 8192, lane); \
        } } while (0)
    for (int j = 0; j < NT; j += 2) {
        FLASH_TILE(j, 0);
        *(LAS u32x4*)(lds + 8192 + kst) = krA; *(LAS u32x4*)(lds + 16384 + 8192 + vst) = vrA; w2 = wA;
        if (j + 3 < NT) { krA = *(const GAS u32x4*)(kg + (size_t)(j + 3) * tstep); vrA = *(const GAS u32x4*)(vg + (size_t)(j + 3) * tstep); if (MODE == 1) wA = *(const GAS u32x2*)(selp + 2 * (j + 3)); }
        __syncthreads();
        FLASH_TILE(j + 1, 1);
        if (j + 2 < NT) { *(LAS u32x4*)(lds + kst) = krB; *(LAS u32x4*)(lds + 16384 + vst) = vrB; w2 = wB; }
        if (j + 4 < NT) { krB = *(const GAS u32x4*)(kg + (size_t)(j + 4) * tstep); vrB = *(const GAS u32x4*)(vg + (size_t)(j + 4) * tstep); if (MODE == 1) wB = *(const GAS u32x2*)(selp + 2 * (j + 4)); }
        __syncthreads();
    }
#undef FLASH_TILE
    lsum = xsum(lsum);
    store_ot(ot, 1.0f / lsum, Op + (size_t)qs * ldo, ldo, lds + 49152 + wid * 4608, lane);
    __syncthreads();
}

__device__ __forceinline__ void sb_tile(f32x16& p0, f32x16& p1, float& Pr, int hi) {
    float og[8], tg[8];
#pragma unroll
    for (int kb = 0; kb < 2; ++kb)
#pragma unroll
        for (int g = 0; g < 4; ++g) {
            float b[4], om[4];
#pragma unroll
            for (int e = 0; e < 4; ++e) { const float z = kb ? p1[4 * g + e] : p0[4 * g + e];
                const float u = __builtin_amdgcn_exp2f(-fmaxf(z, -120.f)); b[e] = __builtin_amdgcn_rcpf(1.0f + u); om[e] = (z < -1.0e29f) ? 1.0f : u * b[e]; if (z < -1.0e29f) b[e] = 0.f; }
            const float e2 = om[3], e1 = e2 * om[2], e0 = e1 * om[1];
            og[4 * kb + g] = e0 * om[0];
            if (kb) { p1[4 * g + 0] = b[0] * e0; p1[4 * g + 1] = b[1] * e1; p1[4 * g + 2] = b[2] * e2; p1[4 * g + 3] = b[3]; }
            else    { p0[4 * g + 0] = b[0] * e0; p0[4 * g + 1] = b[1] * e1; p0[4 * g + 2] = b[2] * e2; p0[4 * g + 3] = b[3]; }
        }
#pragma unroll
    for (int i = 0; i < 8; ++i) tg[i] = __shfl_xor(og[i], 32);
    float suf = Pr;
#pragma unroll
    for (int i = 7; i >= 0; --i) {
        const float mul = suf * ((hi == 0) ? tg[i] : 1.0f);
        const int kb = i >> 2, g = i & 3;
#pragma unroll
        for (int e = 0; e < 4; ++e) { if (kb) p1[4 * g + e] *= mul; else p0[4 * g + e] *= mul; }
        suf *= og[i] * tg[i];
    }
    Pr = suf;
}
template <int ld, int ldo> __device__ __forceinline__ void sb_unit(LAS unsigned char* lds, const GAS bf16_t* Qp  , const GAS bf16_t* Kp, const GAS bf16_t* Vp, GAS bf16_t* Op, int qb) {
    const int tid = otid(), lane = tid & 63, wid = __builtin_amdgcn_readfirstlane(tid >> 6), ql = lane & 31, hi = lane >> 5;
    const int blk = (wid < 4) ? 2 * wid : 2 * (wid - 4) + 1;
    const int qs = qb * 256 + blk * 32, qq = qs + ql;
    LAS unsigned char* vimg = lds + wid * 8192;
    LAS unsigned char* kimg = lds + 65536 + wid * 8192;
    bf16x8 qf[4];
    { const GAS bf16_t* qp = Qp + (size_t)qq * ld + 8 * hi;
#pragma unroll
      for (int ks = 0; ks < 4; ++ks) qf[ks] = *(const GAS bf16x8*)(qp + 16 * ks); }
    f32x16 ot[2]; ot[0] = (f32x16){}; ot[1] = (f32x16){};
    float R = 1.f;
    const int vc = lane & 7;
    const unsigned vwo = (unsigned)((vc >> 2) * 4096 + (lane >> 3) * 64 + (vc & 3) * 16);
    const int kr = lane >> 3;
    const unsigned kce = (unsigned)(((vc ^ (kr >> 1)) << 4) + kr * 128);
    const unsigned kfb = (unsigned)(ql * 128); const int kswz = (ql >> 1) & 7;
    u32x4 kk[8], vv[8];
    { const int j = qs >> 6;
      const GAS bf16_t* kg = Kp + (size_t)(64 * j + kr) * ld + vc * 8; const GAS bf16_t* vg = Vp + (size_t)(64 * j + (lane >> 3)) * ld + vc * 8;
#pragma unroll
      for (int i = 0; i < 8; ++i) kk[i] = *(const GAS u32x4*)(kg + (size_t)(8 * i) * ld);
#pragma unroll
      for (int i = 0; i < 8; ++i) vv[i] = *(const GAS u32x4*)(vg + (size_t)(8 * i) * ld); }
    const int jd = qs >> 6;
    for (int j = jd; j >= 0; --j) {
#pragma unroll
        for (int i = 0; i < 8; ++i) *(LAS u32x4*)(vimg + vwo + i * 512) = vv[i];
#pragma unroll
        for (int i = 0; i < 8; ++i) *(LAS u32x4*)(kimg + i * 1024 + ((i & 1) ? (kce ^ 64u) : kce)) = kk[i];
        CFENCE();
        bf16x8 kf[2][4];
#pragma unroll
        for (int ks = 0; ks < 4; ++ks) { kf[0][ks] = *(const LAS bf16x8*)(kimg + kfb + (((2 * ks + hi) ^ kswz) << 4)); kf[1][ks] = *(const LAS bf16x8*)(kimg + 4096 + kfb + (((2 * ks + hi) ^ kswz) << 4)); }
        f32x16 p0 = (f32x16){}, p1 = (f32x16){};
#pragma unroll
        for (int ks = 0; ks < 4; ++ks) {
            p0 = __builtin_amdgcn_mfma_f32_32x32x16_bf16(kf[0][ks], qf[ks], p0, 0, 0, 0);
            p1 = __builtin_amdgcn_mfma_f32_32x32x16_bf16(kf[1][ks], qf[ks], p1, 0, 0, 0); }
        if (j > 0) {
            const GAS bf16_t* kg = Kp + (size_t)(64 * (j - 1) + kr) * ld + vc * 8; const GAS bf16_t* vg = Vp + (size_t)(64 * (j - 1) + (lane >> 3)) * ld + vc * 8;
#pragma unroll
            for (int i = 0; i < 8; ++i) kk[i] = *(const GAS u32x4*)(kg + (size_t)(8 * i) * ld);
#pragma unroll
            for (int i = 0; i < 8; ++i) vv[i] = *(const GAS u32x4*)(vg + (size_t)(8 * i) * ld);
        }
        if (j == jd) {
            const int kbase = 64 * j + 4 * hi;
#pragma unroll
            for (int r = 0; r < 16; ++r) { const int key = kbase + 8 * (r >> 2) + (r & 3); if (key >= qq) p0[r] = NEGBIG; if (key + 32 >= qq) p1[r] = NEGBIG; }
        }
        sb_tile(p0, p1, R, hi);
        pv_tile(ot, p0, p1, vimg, lane);
        CFENCE();
        if (__all(R < 1.0e-38f)) break;
    }
    store_ot(ot, 1.0f, Op + (size_t)qs * ldo, ldo, lds + 65536 + wid * 8192, lane);
}

__device__ __forceinline__ int count_ge4(unsigned a0, unsigned a1, unsigned a2, unsigned a3, unsigned cand) {
    unsigned long long m0, m1, m2, m3;
    asm volatile("v_cmp_ge_u32_e64 %0, %4, %8\n\tv_cmp_ge_u32_e64 %1, %5, %8\n\tv_cmp_ge_u32_e64 %2, %6, %8\n\tv_cmp_ge_u32_e64 %3, %7, %8"
                 : "=&s"(m0), "=&s"(m1), "=&s"(m2), "=&s"(m3) : "v"(a0), "v"(a1), "v"(a2), "v"(a3), "s"(cand));
    return (__builtin_popcountll(m0) + __builtin_popcountll(m1)) + (__builtin_popcountll(m2) + __builtin_popcountll(m3));
}

__device__ __forceinline__ void idx_tile(LAS unsigned char* lds, const GAS bf16_t* CBb  , const GAS bf16_t* KIb, const GAS float* WIb, GAS unsigned* SELb, int qt) {
    const int tid = otid(), lane = tid & 63, wid = __builtin_amdgcn_readfirstlane(tid >> 6);
    const int t0 = 16 * qt;
    LAS float* sc = (LAS float*)lds;
    if (t0 + 15 < 256) {
#pragma unroll
        for (int rr = 0; rr < 2; ++rr) { const int t = t0 + 2 * wid + rr; const int n = t + 1 - 32 * lane;
            const unsigned selm = (n >= 32) ? 0xffffffffu : ((n <= 0) ? 0u : ((1u << n) - 1u));
            SELb[(size_t)t * 64 + lane] = ~selm; }
        return;
    }
    const int nkt = qt + 1;
    {
        const int qi_ = lane & 15, kq = lane >> 4;
        bf16x8 qf[4][2];
        const GAS bf16_t* qp = CBb + (size_t)(t0 + qi_) * 1024 + 768 + 8 * kq;
#pragma unroll
        for (int h = 0; h < 4; ++h) { qf[h][0] = *(const GAS bf16x8*)(qp + h * 64); qf[h][1] = *(const GAS bf16x8*)(qp + h * 64 + 32); }
        const f32x4 wv = *(const GAS f32x4*)(WIb + (size_t)(t0 + qi_) * 4);
        for (int kt0 = wid; kt0 < nkt; kt0 += 32) {
            bf16x8 k0[4], k1[4];
#pragma unroll
            for (int u = 0; u < 4; ++u) { const int kt = kt0 + 8 * u; const int ktc = kt < nkt ? kt : 0;
                const GAS bf16_t* kp = KIb + (size_t)(16 * ktc + qi_) * 64 + 8 * kq; k0[u] = *(const GAS bf16x8*)kp; k1[u] = *(const GAS bf16x8*)(kp + 32); }
#pragma unroll
            for (int u = 0; u < 4; ++u) { const int kt = kt0 + 8 * u;
                if (kt < nkt) {
                    f32x4 s = {0.f, 0.f, 0.f, 0.f};
#pragma unroll
                    for (int h = 0; h < 4; ++h) { f32x4 d = {0.f, 0.f, 0.f, 0.f};
                        d = __builtin_amdgcn_mfma_f32_16x16x32_bf16(k0[u], qf[h][0], d, 0, 0, 0);
                        d = __builtin_amdgcn_mfma_f32_16x16x32_bf16(k1[u], qf[h][1], d, 0, 0, 0);
#pragma unroll
                        for (int e = 0; e < 4; ++e) s[e] += wv[h] * fmaxf(d[e], 0.f); }
                    *(LAS f32x4*)(sc + qi_ * 2052 + 16 * kt + 4 * kq) = s;
                } }
        }
    }
    __syncthreads();
    LAS unsigned* cbuf = (LAS unsigned*)(lds + 131328 + wid * 256);
#pragma unroll 1
    for (int rr = 0; rr < 2; ++rr) {
        const int q = 2 * wid + rr, t = t0 + q;
        const int ng = (t >> 8) + 1;
        unsigned u[32];
#pragma unroll
        for (int g = 0; g < 8; ++g) {
            if (g < ng) {
#pragma unroll
                for (int k = 0; k < 4; ++k) { const int i = 4 * g + k; const int s = 64 * i + lane; const unsigned b = __float_as_uint(sc[q * 2052 + s]);
                    const unsigned key = (b & 0x80000000u) ? ~b : (b | 0x80000000u); u[i] = (s <= t) ? key : 0u; }
            } else {
#pragma unroll
                for (int k = 0; k < 4; ++k) u[4 * g + k] = 0u;
            }
        }
        unsigned T = 0u; int exact = 0, n_ge = 256 * ng, n_hi = 0, bit = 31;
#pragma unroll 1
        for (; bit >= 0; --bit) {
            if (n_ge - n_hi <= 64) break;
            const unsigned cand = T | (1u << bit); int cnt = 0;
#pragma unroll
            for (int g = 0; g < 8; ++g) if (g < ng) cnt += count_ge4(u[4 * g], u[4 * g + 1], u[4 * g + 2], u[4 * g + 3], cand);
            if (cnt >= 256) { T = cand; n_ge = cnt; } else n_hi = cnt;
            if (cnt == 256) { exact = 1; break; }
        }
        if (!exact && bit >= 0) {
            const unsigned range = 2u << bit; int base = 0;
#pragma unroll
            for (int g = 0; g < 8; ++g) if (g < ng) {
#pragma unroll
                for (int k = 0; k < 4; ++k) { const int i = 4 * g + k; const bool act = (u[i] - T) < range; const unsigned long long m = __ballot(act);
                    const int pos = base + (int)__builtin_amdgcn_mbcnt_hi((unsigned)(m >> 32), __builtin_amdgcn_mbcnt_lo((unsigned)m, 0u));
                    if (act) cbuf[pos] = u[i]; base += __builtin_popcountll(m); } }
            CFENCE();
            const unsigned a = (lane < base) ? cbuf[lane] : 0u;
            CFENCE();
#pragma unroll 1
            for (; bit >= 0; --bit) {
                const unsigned cand = T | (1u << bit);
                const int cnt = n_hi + __builtin_popcountll(__ballot(a >= cand));
                if (cnt >= 256) T = cand;
                if (cnt == 256) { exact = 1; break; }
            }
        }
        asm volatile("" : "+s"(T), "+s"(exact));
        int need = 0;
        if (!exact) { int cgt = 0;
#pragma unroll
            for (int g = 0; g < 8; ++g) if (g < ng) {
#pragma unroll
                for (int k = 0; k < 4; ++k) cgt += __builtin_popcountll(__ballot(u[4 * g + k] > T)); }
            need = 256 - cgt; }
        unsigned word = 0xffffffffu; int cum = 0;
#pragma unroll
        for (int g = 0; g < 8; ++g) if (g < ng) {
#pragma unroll
            for (int k = 0; k < 4; ++k) { const int i = 4 * g + k;
                bool sel;
                if (exact) sel = (u[i] >= T);
                else { const bool eq = (u[i] == T); const unsigned long long em = __ballot(eq);
                    const int rank = (int)__builtin_amdgcn_mbcnt_hi((unsigned)(em >> 32), __builtin_amdgcn_mbcnt_lo((unsigned)em, 0u));
                    sel = (u[i] > T) || (eq && (cum + rank < need)); cum += __builtin_popcountll(em); }
                const unsigned long long sm = ~__ballot(sel);
                if ((lane >> 1) == i) word = (lane & 1) ? (unsigned)(sm >> 32) : (unsigned)sm; } }
        SELb[(size_t)t * 64 + lane] = word;
    }
    __syncthreads();
}
}

__device__ __forceinline__ float wave_sum(float v) {
#pragma unroll
    for (int o = 1; o < 64; o <<= 1) v += __shfl_xor(v, o);
    return v;
}
__device__ __forceinline__ int small_src(int j) { return j < 64 ? 4104 + j : (j < 72 ? 3072 + (j - 64) : (j < 76 ? 4168 + (j - 72) : -1)); }
__device__ __forceinline__ void tp_item(const GAS float* W, int ldsrc, int K, int k0, int src_col0, int small_j0, const GAS float* gain, GAS bf16_t* WT, int dst_row0, LAS float* scr, int lane) {
    const int nn = lane & 31; const int scol = (src_col0 >= 0) ? (src_col0 + nn) : small_src(small_j0 + nn);
#pragma unroll 8
    for (int i = 0; i < 32; ++i) { const int kk = 2 * i + (lane >> 5); float v = 0.f; if (scol >= 0) v = W[(size_t)(k0 + kk) * ldsrc + scol]; if (gain) v *= gain[k0 + kk]; scr[kk * 33 + nn] = v; }
    asm volatile("s_waitcnt lgkmcnt(0)" ::: "memory");
    const int c = lane & 7;
#pragma unroll
    for (int j = 0; j < 4; ++j) { const int n = (lane >> 3) + 8 * j; const LAS float* s = scr + (8 * c) * 33 + n;
        u32x4 o; o.x = pk2(s[0 * 33], s[1 * 33]); o.y = pk2(s[2 * 33], s[3 * 33]); o.z = pk2(s[4 * 33], s[5 * 33]); o.w = pk2(s[6 * 33], s[7 * 33]);
        *(GAS u32x4*)(WT + (size_t)(dst_row0 + n) * K + k0 + 8 * c) = o; }
    asm volatile("s_waitcnt lgkmcnt(0)" ::: "memory");
}
__device__ __forceinline__ void tp_item64(const GAS float* W, int ldsrc, int K, int k0, int src_col0, const GAS float* gain, GAS bf16_t* WT, int dst_row0, LAS float* scr, int lane) {
    const int c4 = lane & 15, kr = lane >> 4;
    f32x4 v[16];
#pragma unroll
    for (int i = 0; i < 16; ++i) v[i] = *(const GAS f32x4*)(W + (size_t)(k0 + 4 * i + kr) * ldsrc + src_col0 + 4 * c4);
#pragma unroll
    for (int i = 0; i < 16; ++i) { LAS float* d = scr + (4 * i + kr) * 65 + 4 * c4; d[0] = v[i][0]; d[1] = v[i][1]; d[2] = v[i][2]; d[3] = v[i][3]; }
    asm volatile("s_waitcnt lgkmcnt(0)" ::: "memory");
    const int c = lane & 7;
    f32x4 g0 = {1.f, 1.f, 1.f, 1.f}, g1 = g0;
    if (gain) { g0 = *(const GAS f32x4*)(gain + k0 + 8 * c); g1 = *(const GAS f32x4*)(gain + k0 + 8 * c + 4); }
#pragma unroll
    for (int j = 0; j < 8; ++j) { const int n = (lane >> 3) + 8 * j; const LAS float* s = scr + (8 * c) * 65 + n;
        u32x4 o; o.x = pk2(s[0 * 65] * g0[0], s[1 * 65] * g0[1]); o.y = pk2(s[2 * 65] * g0[2], s[3 * 65] * g0[3]); o.z = pk2(s[4 * 65] * g1[0], s[5 * 65] * g1[1]); o.w = pk2(s[6 * 65] * g1[2], s[7 * 65] * g1[3]);
        *(GAS u32x4*)(WT + (size_t)(dst_row0 + n) * K + k0 + 8 * c) = o; }
    asm volatile("s_waitcnt lgkmcnt(0)" ::: "memory");
}

struct Args { const float* in[11]; const int* pos; float* out; unsigned char* ws; int ph_lo, ph_hi; };
constexpr int N_PHASES = 24;
#ifndef PH_INLINE
#define PH_INLINE __forceinline__
#endif

__device__ PH_INLINE void ph_prep(LAS unsigned char* lds, unsigned char* ws, const float* w_in_, const float* g_mix_, const float* w_br_, const float* w_out_, const float* g_mlp_, const float* w_up_, const float* w_dn_, const int* pos_) {
    ws = optr(ws);
    const GAS float* w_in = (const GAS float*)w_in_; const GAS float* g_mix = (const GAS float*)g_mix_; const GAS float* w_br = (const GAS float*)w_br_; const GAS float* w_out = (const GAS float*)w_out_;
    const GAS float* g_mlp = (const GAS float*)g_mlp_; const GAS float* w_up = (const GAS float*)w_up_; const GAS float* w_dn = (const GAS float*)w_dn_; const GAS int* pos = (const GAS int*)pos_;
    const int tid = otid(), lane = tid & 63, wave = __builtin_amdgcn_readfirstlane(tid >> 6);
    const int G = gridDim.x, bx = blockIdx.x, gw = bx * NWAVES + wave, NGW = G * NWAVES;
    GAS float* CS = (GAS float*)(ws + WS_CS);
    LAS float* scr = (LAS float*)(lds + wave * 17408);
    constexpr int I_IN = 16 * 112, I_SM = 16 * 8, I_BR = 3 * 8 * 16, I_OUT = 16 * 16, I_UP = 16 * 64, I_DN = 64 * 16, I_L = I_IN + I_SM + I_BR + I_OUT + I_UP + I_DN;
    for (int it = gw; it < 2 * I_L; it += NGW) {
        const int l = it / I_L; int r = it - l * I_L;
        GAS unsigned char* wl = (GAS unsigned char*)(ws + WS_W + (size_t)l * W_LAYER);
        if (r < I_IN) { const int kb = r / 112, nb = r % 112, row = 64 * nb; int src;
            if (row < 3072) src = row; else if (row < 3584) src = 3080 + (row - 3072); else if (row < 3712) src = 3592 + (row - 3584); else if (row < 3840) src = 3720 + (row - 3712);
            else if (row < 4096) src = 3848 + (row - 3840); else src = 4172 + (row - 4096);
            tp_item64(w_in + (size_t)l * DM * COLT, COLT, DM, 64 * kb, src, g_mix + l * DM, (GAS bf16_t*)(wl + W_IN), row, scr, lane); continue; }
        r -= I_IN;
        if (r < I_SM) { const int kb = r / 8, nb = r % 8;
            tp_item(w_in + (size_t)l * DM * COLT, COLT, DM, 64 * kb, -1, 32 * nb, g_mix + l * DM, (GAS bf16_t*)(wl + W_IN), 7168 + 32 * nb, scr, lane); continue; }
        r -= I_SM;
        if (r < I_BR) { const int b = r / 128, r2 = r % 128, kb = r2 / 16, nb = r2 % 16;
            tp_item64(w_br + ((size_t)l * 3 + b) * 512 * DM, DM, 512, 64 * kb, 64 * nb, nullptr, (GAS bf16_t*)(wl + W_BR) + (size_t)b * DM * 512, 64 * nb, scr, lane); continue; }
        r -= I_BR;
        if (r < I_OUT) { const int kb = r / 16, nb = r % 16;
            tp_item64(w_out + (size_t)l * DM * DM, DM, DM, 64 * kb, 64 * nb, nullptr, (GAS bf16_t*)(wl + W_OUT), 64 * nb, scr, lane); continue; }
        r -= I_OUT;
        if (r < I_UP) { const int kb = r / 64, nb = r % 64;
            tp_item64(w_up + (size_t)l * DM * FF, FF, DM, 64 * kb, 64 * nb, g_mlp + l * DM, (GAS bf16_t*)(wl + W_UP), 64 * nb, scr, lane); continue; }
        r -= I_UP;
        { const int kb = r / 16, nb = r % 16;
            tp_item64(w_dn + (size_t)l * FF * DM, DM, FF, 64 * kb, 64 * nb, nullptr, (GAS bf16_t*)(wl + W_DN), 64 * nb, scr, lane); }
    }
    for (int i = bx * (NWAVES * 64) + tid; i < MTOK * 8; i += G * NWAVES * 64) {
        const int tok = i >> 3, f = i & 7;
        const float invf = (f == 0) ? 1.0f : (f == 1) ? 0.1939227432012558f : (f == 2) ? 0.03760603070259094f : (f == 3) ? 0.007292664609849453f : (f == 4) ? 0.0014142135623842478f
                          : (f == 5) ? 0.00027424818836152554f : (f == 6) ? 5.318296098266728e-05f : 1.0313386155758053e-05f;
        const float ang = (float)pos[tok] * invf;
        CS[(size_t)tok * 16 + f] = cosf(ang); CS[(size_t)tok * 16 + 8 + f] = sinf(ang);
    }
}
__device__ PH_INLINE void ph_xprep(unsigned char* ws, const float* xcur_) {
    ws = optr(ws);
    const GAS float* xcur = (const GAS float*)xcur_;
    const int tid = otid(), lane = tid & 63, wave = __builtin_amdgcn_readfirstlane(tid >> 6);
    const int gw = blockIdx.x * NWAVES + wave, NGW = gridDim.x * NWAVES;
    GAS bf16_t* XB = (GAS bf16_t*)(ws + WS_XB); GAS float* SS0 = (GAS float*)(ws + WS_CTL + SS_OFF);
    for (int m = gw; m < MTOK; m += NGW) {
        const GAS f32x4* xr = (const GAS f32x4*)(xcur + (size_t)m * DM) + lane; f32x4 v[4]; float s = 0.f;
#pragma unroll
        for (int j = 0; j < 4; ++j) { v[j] = xr[64 * j]; s += (v[j][0] * v[j][0] + v[j][1] * v[j][1]) + (v[j][2] * v[j][2] + v[j][3] * v[j][3]); }
        s = wave_sum(s);
        if (lane == 0) SS0[m] = s;
        GAS u32x2* o8 = (GAS u32x2*)(XB + (size_t)m * DM) + lane;
#pragma unroll
        for (int j = 0; j < 4; ++j) { u32x2 w; w.x = pk2(v[j][0], v[j][1]); w.y = pk2(v[j][2], v[j][3]); o8[64 * j] = w; }
    }
}
__device__ __forceinline__ void inproj_tail(LAS unsigned char* lds, unsigned char* ws, unsigned char* wl, bf16_t* XB, const GAS float* SS, const float* bfg_, int tok0) {
    const int G = gridDim.x, bx = blockIdx.x;
    const int tid = otid(), lane = tid & 63, wid = __builtin_amdgcn_readfirstlane(tid >> 6), rg = wid & 3, kh = wid >> 2, tl = lane & 15, g4 = lane >> 4;
    const GAS float* bfg = (const GAS float*)bfg_;
    const GAS float* CS = (const GAS float*)(ws + WS_CS);
    GAS bf16_t* KI = (GAS bf16_t*)(ws + WS_KI); GAS float* WI = (GAS float*)(ws + WS_WI); GAS float* LF = (GAS float*)(ws + WS_LF);
    LAS f32x4* xch = (LAS f32x4*)lds;
    for (int grp = bx; grp < MH / 64; grp += G) {
        const int row = grp * 64 + rg * 16 + tl;
        const GAS bf16_t* xp = (const GAS bf16_t*)XB + (size_t)(tok0 + row) * DM + kh * 512 + 8 * g4;
        const GAS bf16_t* wp = (const GAS bf16_t*)(wl + W_IN) + (size_t)(7168 + tl) * DM + kh * 512 + 8 * g4;
        f32x4 acc[5];
#pragma unroll
        for (int nt = 0; nt < 5; ++nt) acc[nt] = (f32x4){0.f, 0.f, 0.f, 0.f};
#pragma unroll 1
        for (int kb = 0; kb < 16; kb += 4) {
            bf16x8 xf[4], wf[4][5];
#pragma unroll
            for (int u = 0; u < 4; ++u) { xf[u] = *(const GAS bf16x8*)(xp + 32 * (kb + u));
#pragma unroll
                for (int nt = 0; nt < 5; ++nt) wf[u][nt] = *(const GAS bf16x8*)(wp + (size_t)(16 * nt) * DM + 32 * (kb + u)); }
#pragma unroll
            for (int u = 0; u < 4; ++u)
#pragma unroll
                for (int nt = 0; nt < 5; ++nt) acc[nt] = __builtin_amdgcn_mfma_f32_16x16x32_bf16(wf[u][nt], xf[u], acc[nt], 0, 0, 0);
        }
        if (kh == 1) {
#pragma unroll
            for (int nt = 0; nt < 5; ++nt) xch[(rg * 5 + nt) * 64 + lane] = acc[nt];
        }
        __syncthreads();
        if (kh == 0) {
            const float rs = pg8::rs_of(SS[tok0 + row]);
#pragma unroll
            for (int nt = 0; nt < 5; ++nt) acc[nt] = (acc[nt] + xch[(rg * 5 + nt) * 64 + lane]) * rs;
            { const f32x4 cs = *(const GAS f32x4*)(CS + (size_t)(tok0 + row) * 16 + 4 * (g4 & 1)), sn = *(const GAS f32x4*)(CS + (size_t)(tok0 + row) * 16 + 8 + 4 * (g4 & 1));
              const float sg = (g4 < 2) ? -1.f : 1.f; f32x4 v = acc[0];
#pragma unroll
              for (int e = 0; e < 4; ++e) { const float p = __shfl_xor(v[e], 32); v[e] = v[e] * cs[e] + sg * p * sn[e]; }
              acc[0] = v; }
#pragma unroll
            for (int nt = 0; nt < 4; ++nt) { u32x2 w; w.x = pk2(acc[nt][0], acc[nt][1]); w.y = pk2(acc[nt][2], acc[nt][3]); *(GAS u32x2*)(KI + (size_t)row * 64 + 16 * nt + 4 * g4) = w; }
            if (g4 < 2) { const int bl = row >> 11, t = row & 2047; GAS float* lp = LF + ((size_t)bl * 8 + 4 * g4) * SEQ + t;
#pragma unroll
                for (int e = 0; e < 4; ++e) lp[(size_t)e * SEQ] = pg8::logsigmoidf_(acc[4][e] + bfg[4 * g4 + e]) * LOG2E; }
            else if (g4 == 2) *(GAS f32x4*)(WI + (size_t)row * 4) = acc[4] * 0.5f;
        }
        __syncthreads();
    }
}
__device__ PH_INLINE void ph_inproj(LAS unsigned char* lds, unsigned char* ws, const float* bfg_, int l, int hf) {
    ws = optr(ws);
    const int G = gridDim.x, bx = blockIdx.x; const int tok0 = hf * MH;
    unsigned char* wl = ws + WS_W + (size_t)l * W_LAYER;
    bf16_t* XB = (bf16_t*)(ws + WS_XB);
    const GAS float* SS = (const GAS float*)(ws + WS_CTL + SS_OFF + (size_t)(2 * l) * SS_STRIDE);
    const bool tail_first = (bx & 1) != 0;
    if (tail_first) inproj_tail(lds, ws, wl, XB, SS, bfg_, tok0);
    {
        pg8::TileOrder<MH / 256, 28, 1, DM, DM, 0, 0, 0> S; S.G = G; S.c = bx;
        S.A = (const char*)(XB + (size_t)tok0 * DM); S.B = (const char*)(wl + W_IN);
        pg8::EpiInProj E{(GAS bf16_t*)(ws + WS_QKV), (GAS bf16_t*)(ws + WS_CB), (GAS unsigned char*)(ws + WS_G), (GAS bf16_t*)(ws + WS_KI), (GAS float*)(ws + WS_WI), (GAS float*)(ws + WS_LF), SS, (const GAS float*)(ws + WS_CS), (const GAS float*)bfg_, tok0};
        pg8::gemm_phase<DM, DM, DM>(lds, S, E);
    }
    if (!tail_first) inproj_tail(lds, ws, wl, XB, SS, bfg_, tok0);
}
template <int UMASK, bool DUMMY>
__device__ PH_INLINE void ph_att1(LAS unsigned char* lds, unsigned char* ws, unsigned* qctr, int tok0) {
    volatile LAS unsigned* MISC = (volatile LAS unsigned*)(lds + MISC_OFF);
    const int tid = otid(); ws = optr(ws);
    GAS bf16_t* QKV = (GAS bf16_t*)(ws + WS_QKV); GAS bf16_t* CB = (GAS bf16_t*)(ws + WS_CB); GAS bf16_t* KI = (GAS bf16_t*)(ws + WS_KI); GAS float* WI = (GAS float*)(ws + WS_WI); GAS float* LF = (GAS float*)(ws + WS_LF); GAS unsigned* SEL = (GAS unsigned*)(ws + WS_SEL);
    GAS bf16_t* YD = (GAS bf16_t*)(ws + WS_Y) + (size_t)tok0 * 1024;
    const bool stat = (gridDim.x == 256);
    if (stat && (UMASK & 1)) {
        const int bx = blockIdx.x, vcu = (bx & 7) * 32 + (bx >> 3), bh = vcu >> 2, sp = vcu & 3, bl = bh >> 3, h = bh & 7;
        GAS bf16_t* base = QKV + (size_t)bl * SEQ * 3072 + h * 64;
#pragma unroll 1
        for (int r = 0; r < 2; ++r) { const int qb = r ? sp : 7 - sp;
            if (DUMMY) att::flash_unit<0, 3072, 3072, 1024>(lds, base + 1536, base + 2048, base + 2560, YD + (size_t)bl * SEQ * 1024 + 512 + h * 64, qb, LF + (size_t)(bl * 8 + h) * SEQ, nullptr);
            else att::flash_unit<0, 3072, 3072, 3072>(lds, base + 1536, base + 2048, base + 2560, base + 1536, qb, LF + (size_t)(bl * 8 + h) * SEQ, nullptr); }
    }
    if (stat) {
        if (UMASK & 4) {
            const int bx = blockIdx.x, vcu = (bx & 7) * 32 + (bx >> 3), bh = vcu >> 2, sp = vcu & 3, bl = bh >> 3, h = bh & 7;
            GAS bf16_t* base = QKV + (size_t)bl * SEQ * 3072 + h * 64;
#pragma unroll 1
            for (int r = 0; r < 2; ++r) { const int qb = r ? sp : 7 - sp;
                if (DUMMY) att::sb_unit<3072, 1024>(lds, base, base + 512, base + 1024, YD + (size_t)bl * SEQ * 1024 + h * 64, qb);
                else att::sb_unit<3072, 3072>(lds, base, base + 512, base + 1024, base, qb);
                __syncthreads(); }
        }
        for (;;) {
            if (tid == 0) MISC[0] = __hip_atomic_fetch_add(qctr, 1u, __ATOMIC_RELAXED, __HIP_MEMORY_SCOPE_AGENT);
            __syncthreads();
            const int i = (int)MISC[0];
            __syncthreads();
            if (i >= 1024) break;
            if (UMASK & 2) { const int qt = 127 - (i >> 3), bl = i & 7;
                att::idx_tile(lds, CB + (size_t)bl * SEQ * 1024, KI + (size_t)bl * SEQ * 64, WI + (size_t)bl * SEQ * 4, SEL + (size_t)bl * SEQ * 64, qt); }
        }
        return;
    }
    const int t_off = 0;
    for (;;) {
        if (tid == 0) MISC[0] = __hip_atomic_fetch_add(qctr, 1u, __ATOMIC_RELAXED, __HIP_MEMORY_SCOPE_AGENT);
        __syncthreads();
        const int ui = (int)MISC[0] + t_off;
        __syncthreads();
        if (ui >= 512 + 1536) break;
        const int v = ui - 512;
        if (ui < 512) { if (UMASK & 1) { const int qb = 7 - (ui >> 6), bh = ui & 63, bl = bh >> 3, h = bh & 7;
            GAS bf16_t* base = QKV + (size_t)bl * SEQ * 3072 + h * 64;
            if (DUMMY) att::flash_unit<0, 3072, 3072, 1024>(lds, base + 1536, base + 2048, base + 2560, YD + (size_t)bl * SEQ * 1024 + 512 + h * 64, qb, LF + (size_t)(bl * 8 + h) * SEQ, nullptr);
            else att::flash_unit<0, 3072, 3072, 3072>(lds, base + 1536, base + 2048, base + 2560, base + 1536, qb, LF + (size_t)(bl * 8 + h) * SEQ, nullptr); }
        } else if (v < 1280 && (v % 5) != 4) { if (UMASK & 2) { const int i = (v / 5) * 4 + (v % 5), qt = 127 - (i >> 3), bl = i & 7;
            if (qt >= 0) att::idx_tile(lds, CB + (size_t)bl * SEQ * 1024, KI + (size_t)bl * SEQ * 64, WI + (size_t)bl * SEQ * 4, SEL + (size_t)bl * SEQ * 64, qt); }
        } else { if (UMASK & 4) { const int i = (v < 1280) ? (v / 5) : (256 + (v - 1280)), qb = 7 - (i >> 6), bh = i & 63, bl = bh >> 3, h = bh & 7;
            GAS bf16_t* base = QKV + (size_t)bl * SEQ * 3072 + h * 64;
            if (DUMMY) att::sb_unit<3072, 1024>(lds, base, base + 512, base + 1024, YD + (size_t)bl * SEQ * 1024 + h * 64, qb);
            else att::sb_unit<3072, 3072>(lds, base, base + 512, base + 1024, base, qb);
            __syncthreads(); }
        }
    }
}
__device__ PH_INLINE void ph_att2(LAS unsigned char* lds, unsigned char* ws, unsigned* qctr) {
    volatile LAS unsigned* MISC = (volatile LAS unsigned*)(lds + MISC_OFF);
    const int tid = otid(); ws = optr(ws);
    GAS bf16_t* QKV = (GAS bf16_t*)(ws + WS_QKV); GAS bf16_t* CB = (GAS bf16_t*)(ws + WS_CB); GAS unsigned* SEL = (GAS unsigned*)(ws + WS_SEL);
    const int G = gridDim.x, bx = blockIdx.x;
    if (G == 256) {
        const int vcu = (bx & 7) * 32 + (bx >> 3);
        const int bh = vcu >> 2, sp = vcu & 3, bl = bh >> 3, h = bh & 7;
        const GAS bf16_t* cb = CB + (size_t)bl * SEQ * 1024;
#pragma unroll 1
        for (int i = 0; i < 2; ++i) { const int qb = i ? sp : 7 - sp;
            att::flash_unit<1, 1024, 1024, 3072>(lds, cb + h * 64, cb + 512 + (h >> 2) * 64, cb + 640 + (h >> 2) * 64, QKV + (size_t)bl * SEQ * 3072 + 512 + h * 64, qb, nullptr, SEL + (size_t)bl * SEQ * 64); }
        return;
    }
    for (;;) {
        if (tid == 0) MISC[0] = __hip_atomic_fetch_add(qctr, 1u, __ATOMIC_RELAXED, __HIP_MEMORY_SCOPE_AGENT);
        __syncthreads();
        const int ui = (int)MISC[0];
        __syncthreads();
        if (ui >= 512) break;
        const int qb = 7 - (ui >> 6), bh = ui & 63, bl = bh >> 3, h = bh & 7;
        const GAS bf16_t* cb = CB + (size_t)bl * SEQ * 1024;
        att::flash_unit<1, 1024, 1024, 3072>(lds, cb + h * 64, cb + 512 + (h >> 2) * 64, cb + 640 + (h >> 2) * 64, QKV + (size_t)bl * SEQ * 3072 + 512 + h * 64, qb, nullptr, SEL + (size_t)bl * SEQ * 64);
    }
}
__device__ PH_INLINE void ph_branch(LAS unsigned char* lds, unsigned char* ws, int l, int hf) {
    ws = optr(ws);
    const int G = gridDim.x, bx = blockIdx.x; const int tok0 = hf * MH;
    unsigned char* wl = ws + WS_W + (size_t)l * W_LAYER;
    pg8::TileOrder<MH / 256, 4, 3, 3072, 512, DM * 512, 1536 * 2, 512 * 2> S; S.G = G; S.c = bx;
    S.A = (const char*)(ws + WS_QKV); S.B = (const char*)(wl + W_BR);
    pg8::EpiBranch E{(const GAS unsigned char*)(ws + WS_G), (GAS bf16_t*)(ws + WS_Y), tok0};
    pg8::gemm_phase<512, 3072, 512>(lds, S, E);
}
__device__ PH_INLINE void ph_outproj(LAS unsigned char* lds, unsigned char* ws, int l, const float* xin, float* xout) {
    ws = optr(ws);
    const int G = gridDim.x, bx = blockIdx.x;
    unsigned char* wl = ws + WS_W + (size_t)l * W_LAYER;
    pg8::TileOrder<MTOK / 256, 4, 1, DM, DM, 0, 0, 0> S; S.G = G; S.c = bx;
    S.A = (const char*)(ws + WS_Y); S.B = (const char*)(wl + W_OUT);
    pg8::EpiResid E{(GAS bf16_t*)(ws + WS_XB), (GAS bf16_t*)(ws + WS_XL), (GAS float*)(ws + WS_CTL + SS_OFF + (size_t)(2 * l + 1) * SS_STRIDE), nullptr, nullptr, nullptr, 0, (l == 0) ? (const GAS float*)xin : nullptr};
    pg8::gemm_phase<DM, DM, DM>(lds, S, E);
}
__device__ PH_INLINE void ph_up(LAS unsigned char* lds, unsigned char* ws, int l) {
    ws = optr(ws);
    const int G = gridDim.x, bx = blockIdx.x;
    unsigned char* wl = ws + WS_W + (size_t)l * W_LAYER;
    pg8::TileOrder<MTOK / 256, FF / 256, 1, DM, DM, 0, 0, 0> S; S.G = G; S.c = bx;
    S.A = (const char*)(ws + WS_XB); S.B = (const char*)(wl + W_UP);
    pg8::EpiUp E{(GAS bf16_t*)(ws + WS_HID), (const GAS float*)(ws + WS_CTL + SS_OFF + (size_t)(2 * l + 1) * SS_STRIDE)};
    pg8::gemm_phase<DM, DM, DM>(lds, S, E);
}
__device__ PH_INLINE void ph_down(LAS unsigned char* lds, unsigned char* ws, int l, float* xs, int fin, const float* gfin) {
    ws = optr(ws);
    const int G = gridDim.x, bx = blockIdx.x;
    unsigned char* wl = ws + WS_W + (size_t)l * W_LAYER;
    pg8::TileOrder<MTOK / 256, 4, 1, FF, FF, 0, 0, 0> S; S.G = G; S.c = bx;
    S.A = (const char*)(ws + WS_HID); S.B = (const char*)(wl + W_DN);
    pg8::EpiResid E{(GAS bf16_t*)(ws + WS_XB), (GAS bf16_t*)(ws + WS_XL), (GAS float*)(ws + WS_CTL + SS_OFF + (size_t)(2 * l + 2) * SS_STRIDE), (GAS float*)xs, (const GAS float*)gfin, (GAS unsigned*)(ws + WS_CTL) + CW_FIN, fin, nullptr};
    pg8::gemm_phase<FF, FF, FF>(lds, S, E);
}
__device__ PH_INLINE void ph_final(unsigned char* ws, float* out_, const float* gfin_) {
    GAS float* out = (GAS float*)out_; const GAS float* gfin = (const GAS float*)gfin_;
    const GAS float* SS = (const GAS float*)(ws + WS_CTL + SS_OFF + 4 * SS_STRIDE);
    const GAS bf16_t* XB = (const GAS bf16_t*)(ws + WS_XB); const GAS bf16_t* XL = (const GAS bf16_t*)(ws + WS_XL);
    const int tid = otid(), lane = tid & 63, wave = __builtin_amdgcn_readfirstlane(tid >> 6);
    const int gw = blockIdx.x * NWAVES + wave, NGW = gridDim.x * NWAVES;
    f32x4 g[4];
#pragma unroll
    for (int j = 0; j < 4; ++j) g[j] = ((const GAS f32x4*)gfin)[64 * j + lane];
    for (int m = gw; m < MTOK; m += NGW) {
        GAS f32x4* orow = (GAS f32x4*)(out + (size_t)m * DM) + lane;
        const GAS u32x2* hr = (const GAS u32x2*)(XB + (size_t)m * DM) + lane; const GAS u32x2* lr = (const GAS u32x2*)(XL + (size_t)m * DM) + lane;
        const float rs = pg8::rs_of(SS[m]);
#pragma unroll
        for (int j = 0; j < 4; ++j) { const u32x2 h = hr[64 * j], l = lr[64 * j];
            const f32x4 x = {__uint_as_float(h.x << 16) + __uint_as_float(l.x << 16), __uint_as_float(h.x & 0xffff0000u) + __uint_as_float(l.x & 0xffff0000u),
                             __uint_as_float(h.y << 16) + __uint_as_float(l.y << 16), __uint_as_float(h.y & 0xffff0000u) + __uint_as_float(l.y & 0xffff0000u)};
            orow[64 * j] = x * rs * g[j]; }
    }
}

template <int PHM> __global__ void __launch_bounds__(NWAVES * 64, 2) trunk_fwd(Args args) {
    extern __shared__ __attribute__((aligned(16))) unsigned char lds_raw[];
    LAS unsigned char* lds = (LAS unsigned char*)lds_raw;
    volatile LAS unsigned* MISC = (volatile LAS unsigned*)(lds + MISC_OFF);
    unsigned char* ws = args.ws;
    unsigned* ctl = (unsigned*)(ws + WS_CTL);
    float* xs = args.out;
    if (threadIdx.x < 64) MISC[threadIdx.x] = 0u;
    __syncthreads();
    const int lo = args.ph_lo, hi = args.ph_hi;
    XcdBarrier bar; bar.bar = ctl + CW_BAR; bar.x = 0; bar.st = nullptr;
    if (hi - lo > 1) bar = xcd_barrier_post(ctl + CW_BAR, MISC + 8);
#define SITE(n) (((PHM) >> (n)) & 1)
#define IN(k) (lo <= (k) && (k) < hi)
#define SEAM(k) do { if ((k) + 1 < hi) xcd_barrier(bar); } while (0)
#define DUP(n) (((PROBE_DUP) >> (n)) & 1)
    int k = 0;
    const bool fuse_fin = (MK_ONE_LAUNCH != 0) && (gridDim.x == 256);
    if (SITE(0) && IN(k)) { ph_prep(lds, ws, args.in[3], args.in[2], args.in[5], args.in[6], args.in[7], args.in[8], args.in[9], args.pos); ph_xprep(ws, args.in[0]);
        if (DUP(0)) { xcd_barrier(bar); ph_prep(lds, ws, args.in[3], args.in[2], args.in[5], args.in[6], args.in[7], args.in[8], args.in[9], args.pos); ph_xprep(ws, args.in[0]); } SEAM(k); }
    ++k;
    for (int l = 0; l < 2; ++l) {
        const float* xcur = (l == 0) ? args.in[0] : xs;
        for (int hf = 0; hf < 2; ++hf) {
            if (SITE(2) && IN(k)) { ph_inproj(lds, ws, args.in[4] + l * 8, l, hf); SEAM(k); }
            ++k;
            if (SITE(3) && IN(k)) {
#if PROBE_ATT1
                ph_att1<PROBE_ATT1, true>(lds, ws, ctl + CW_Q + 64 * (16 + (l * 2 + hf) * 2 + 0), hf * MH); xcd_barrier(bar);
#endif
                ph_att1<7, false>(lds, ws, ctl + CW_Q + 64 * ((l * 2 + hf) * 2 + 0), hf * MH); SEAM(k); }
            ++k;
            if (SITE(4) && IN(k)) { ph_att2(lds, ws, ctl + CW_Q + 64 * ((l * 2 + hf) * 2 + 1)); SEAM(k); }
            ++k;
            if (SITE(5) && IN(k)) { ph_branch(lds, ws, l, hf); if (DUP(5)) { xcd_barrier(bar); ph_branch(lds, ws, l, hf); } SEAM(k); }
            ++k;
        }
        if (SITE(6) && IN(k)) { ph_outproj(lds, ws, l, xcur, xs); SEAM(k); }
        ++k;
        if (SITE(8) && IN(k)) { ph_up(lds, ws, l); SEAM(k); }
        ++k;
        if (SITE(9) && IN(k)) { const int fin = (l == 1 && fuse_fin) ? 1 : 0; ph_down(lds, ws, l, xs, fin, args.in[10]); if (!fin) SEAM(k); }
        ++k;
    }
    if (SITE(10) && IN(k) && !fuse_fin) ph_final(ws, xs, args.in[10]);
#undef IN
#undef SEAM
#undef SITE
}

static int site_of_phase(int p) {
    if (p == 0) return 0; if (p == N_PHASES - 1) return 10;
    const int q = (p - 1) % 11;
    if (q < 8) return 2 + (q & 3); if (q == 8) return 6; if (q == 9) return 8; return 9;
}
typedef void (*kern_t)(Args);
extern "C" void kernel_launch(void* const* d_in, const int* in_sizes, int n_in, void* d_out, int out_size, void* d_ws, size_t ws_size, hipStream_t stream) {
    static int grid = 0;
#if MK_ONE_LAUNCH
    static const kern_t kerns[11] = {trunk_fwd<0x7ff>, trunk_fwd<0x7ff>, trunk_fwd<0x7ff>, trunk_fwd<0x7ff>, trunk_fwd<0x7ff>, trunk_fwd<0x7ff>, trunk_fwd<0x7ff>, trunk_fwd<0x7ff>, trunk_fwd<0x7ff>, trunk_fwd<0x7ff>, trunk_fwd<0x7ff>};
#else
    static const kern_t kerns[11] = {trunk_fwd<0x1>, trunk_fwd<0x400>, trunk_fwd<0x4>, trunk_fwd<0x8>, trunk_fwd<0x10>, trunk_fwd<0x20>, trunk_fwd<0x40>, trunk_fwd<0x400>, trunk_fwd<0x100>, trunk_fwd<0x200>, trunk_fwd<0x400>};
#endif
    if (grid == 0) {
        if (n_in != 11 || out_size != MTOK * DM || ws_size < WS_END) { fprintf(stderr, "kernel_launch: unexpected shapes (n_in %d, out %d, ws %zu)\n", n_in, out_size, ws_size); grid = -1; return; }
        int dev = 0, cus = 0;
        if (hipGetDevice(&dev) != hipSuccess || hipDeviceGetAttribute(&cus, hipDeviceAttributeMultiprocessorCount, dev) != hipSuccess) { grid = -1; return; }
        for (int i = 0; i < 11; ++i) {
            if (hipFuncSetAttribute((const void*)kerns[i], hipFuncAttributeMaxDynamicSharedMemorySize, LDS_BYTES) != hipSuccess) { fprintf(stderr, "kernel_launch: hipFuncSetAttribute failed\n"); grid = -1; return; }
            int per_cu = 0;
            if (hipOccupancyMaxActiveBlocksPerMultiprocessor(&per_cu, (const void*)kerns[i], NWAVES * 64, LDS_BYTES) != hipSuccess || per_cu < 1) { fprintf(stderr, "kernel_launch: occupancy query reports %d for site %d\n", per_cu, i); }
        }
        (void)hipGetLastError();
        grid = cus;
    }
    if (grid < 0) return;
    if (hipMemsetAsync((char*)d_ws + WS_CTL, 0, CTL_ZERO_BYTES, stream) != hipSuccess) return;
    Args a{};
    a.in[0] = (const float*)d_in[0]; a.pos = (const int*)d_in[1]; a.in[1] = nullptr;
    for (int i = 2; i < 11; ++i) a.in[i] = (const float*)d_in[i];
    a.out = (float*)d_out; a.ws = (unsigned char*)d_ws;
#if MK_ONE_LAUNCH
    a.ph_lo = 0; a.ph_hi = N_PHASES;
    hipLaunchKernelGGL(kerns[0], dim3(grid), dim3(NWAVES * 64), LDS_BYTES, stream, a);
#else
    for (int p = 0; p < N_PHASES; ++p) { a.ph_lo = p; a.ph_hi = p + 1; hipLaunchKernelGGL(kerns[site_of_phase(p)], dim3(grid), dim3(NWAVES * 64), LDS_BYTES, stream, a); }
#endif
}
```
